# Optimizing an MI355X kernel written in HIP

```python
import jax
import jax.numpy as jnp
from jax import lax
import numpy as np

D_MODEL = 1024
BATCH = 8
SEQ = 2048
DEPTH = 4

N_MIXERS = 3
RMS_EPS = 1e-6

CHUNK = 128
A_WIDTH = D_MODEL
A_GROUPS = 8
A_GROUP_DIM = A_WIDTH // A_GROUPS
LN_EPS = 1e-5

B_WIDTH = D_MODEL
POOL_WINDOWS = (2, 4, 8, 16)
B_GROUPS = len(POOL_WINDOWS)
B_GROUP_DIM = B_WIDTH // B_GROUPS

C_HEAD_DIM = 64
C_HEADS = D_MODEL // C_HEAD_DIM
DECAY_LORA = 64
AAA_LORA = 64
GATE_LORA = 128
GN_EPS = 64e-5
N_SHIFT = 6

D_FF = D_MODEL * 7 // 2
N_EXPERTS = 8
TOP_K = 2
MOE_BLOCK = 128

N_A_LAYERS = (DEPTH + 2) // 3
N_B_LAYERS = (DEPTH + 1) // 3
N_C_LAYERS = DEPTH // 3
N_DENSE_LAYERS = (DEPTH + 1) // 2
N_MOE_LAYERS = DEPTH // 2

kernel_name = "hybrid_gmlp_pool_rwkv7_moe_trunk"


def rmsnorm(x, g):
    xf = x.astype(jnp.float32)
    y = xf * lax.rsqrt(jnp.mean(xf * xf, axis=-1, keepdims=True) + RMS_EPS)
    return (y * g).astype(x.dtype)


def layernorm(x, g, b):
    xf = x.astype(jnp.float32)
    mu = jnp.mean(xf, axis=-1, keepdims=True)
    var = jnp.mean(jnp.square(xf - mu), axis=-1, keepdims=True)
    return ((xf - mu) * lax.rsqrt(var + LN_EPS) * g + b).astype(x.dtype)


def swiglu(x, w_gate, w_up, w_down):
    return (jax.nn.silu(x @ w_gate) * (x @ w_up)) @ w_down


def chunked_gmlp(h, w_in, ln_g, ln_b, w_s, b_s, w_out):
    B, S, _ = h.shape
    z = jax.nn.gelu(h @ w_in, approximate=False)
    u, v = jnp.split(z, 2, axis=-1)
    v = layernorm(v, ln_g, ln_b)
    v = v.reshape(B, S // CHUNK, CHUNK, A_GROUPS, A_GROUP_DIM)
    causal = jnp.tril(jnp.ones((CHUNK, CHUNK), dtype=bool))
    w = jnp.where(causal, w_s, 0).astype(v.dtype)
    s = jnp.einsum('gts,bcsgd->bctgd', w, v) + b_s.T[:, :, None].astype(v.dtype)
    return (u * s.reshape(B, S, A_WIDTH)) @ w_out


def pooling_mixer(h, w_in, w_grp, scale, w_out):
    B, S, _ = h.shape
    p = (h @ w_in).astype(jnp.float32)
    csum = jnp.cumsum(p, axis=1)
    pos = jnp.arange(1, S + 1)
    diffs = []
    for gi, win in enumerate(POOL_WINDOWS):
        lo, hi = gi * B_GROUP_DIM, (gi + 1) * B_GROUP_DIM
        c = csum[..., lo:hi]
        lag = jnp.pad(c, ((0, 0), (win, 0), (0, 0)))[:, :S]
        count = jnp.minimum(pos, win).astype(jnp.float32)[None, :, None]
        diffs.append((c - lag) / count - p[..., lo:hi])
    d = jnp.stack(diffs, axis=2).astype(h.dtype)
    y = jnp.einsum('bsgi,gio->bsgo', d, w_grp).reshape(B, S, B_WIDTH) * scale
    return y @ w_out


def rwkv7_time_mix(h, mu, w_rkv, w0, w1, w2, a0, a1, a2, g1, g2, k_k, k_a, r_k, ln_g, ln_b, w_o):
    B, S, D = h.shape
    f32 = jnp.float32
    xx = jnp.pad(h, ((0, 0), (1, 0), (0, 0)))[:, :S] - h
    xs = h[None] + xx[None] * mu[:, None, None, :]
    r, k, v = jnp.einsum('nbsd,nde->nbse', xs[:3], w_rkv)
    xw, xa, xg = xs[3], xs[4], xs[5]
    w = -jax.nn.softplus(-(w0 + jnp.tanh(xw @ w1) @ w2)) - 0.5
    a = jax.nn.sigmoid(a0 + (xa @ a1) @ a2)
    g = jax.nn.sigmoid(xg @ g1) @ g2

    def heads(t):
        return t.reshape(B, S, C_HEADS, C_HEAD_DIM).astype(f32)

    kk = heads(k * k_k)
    kk = kk / jnp.maximum(jnp.linalg.norm(kk, axis=-1, keepdims=True), 1e-12)
    k = k * (1 + (a - 1) * k_a)
    r_h, k_h, v_h, a_h = heads(r), heads(k), heads(v), heads(a)
    decay = jnp.exp(-jnp.exp(heads(w)))

    def tm(t):
        return jnp.transpose(t, (1, 0, 2, 3))

    def step(state, inp):
        r_t, w_t, k_t, v_t, aa_t, bb_t = inp
        sa = jnp.einsum('bhij,bhj->bhi', state, aa_t)
        state = (state * w_t[:, :, None, :]
                 + sa[..., :, None] * bb_t[..., None, :]
                 + v_t[..., :, None] * k_t[..., None, :])
        return state, jnp.einsum('bhij,bhj->bhi', state, r_t)

    state0 = jnp.zeros((B, C_HEADS, C_HEAD_DIM, C_HEAD_DIM), f32)
    _, y = lax.scan(step, state0, (tm(r_h), tm(decay), tm(k_h), tm(v_h), tm(-kk), tm(kk * a_h)))
    y = tm(y)
    mean = jnp.mean(y, axis=-1, keepdims=True)
    var = jnp.mean(jnp.square(y - mean), axis=-1, keepdims=True)
    yn = ((y - mean) * lax.rsqrt(var + GN_EPS)).reshape(B, S, D) * ln_g + ln_b
    bonus = jnp.sum(r_h * k_h * r_k, axis=-1, keepdims=True) * v_h
    out = (yn + bonus.reshape(B, S, D)).astype(h.dtype) * g
    return out @ w_o


def moe_swiglu(h, router, w_gate, w_up, w_down):
    B, S, D = h.shape
    T = B * S
    x2 = h.reshape(T, D)
    logits = jnp.einsum('td,de->te', x2.astype(jnp.float32), router.astype(jnp.float32))
    top_logit, top_idx = lax.top_k(logits, TOP_K)
    gates = jax.nn.softmax(top_logit, axis=-1).astype(h.dtype)
    flat_e = top_idx.reshape(-1)
    onehot = jax.nn.one_hot(flat_e, N_EXPERTS, dtype=jnp.int32)
    rank = jnp.take_along_axis(jnp.cumsum(onehot, axis=0), flat_e[:, None], axis=1)[:, 0] - 1
    counts = jnp.sum(onehot, axis=0)
    padded = (counts + MOE_BLOCK - 1) // MOE_BLOCK * MOE_BLOCK
    pad_end = jnp.cumsum(padded)
    pad_start = pad_end - padded
    dest = pad_start[flat_e] + rank
    n_blocks = -(-(T * TOP_K) // MOE_BLOCK) + N_EXPERTS
    tok = jnp.arange(T * TOP_K) // TOP_K
    buf = jnp.zeros((n_blocks * MOE_BLOCK, D), h.dtype).at[dest].set(x2[tok])
    block_start = jnp.arange(n_blocks) * MOE_BLOCK
    block_expert = jnp.minimum(jnp.sum(block_start[:, None] >= pad_end[None, :], axis=1), N_EXPERTS - 1)

    def expert_block(args):
        xb, e = args
        return swiglu(xb, w_gate[e], w_up[e], w_down[e])

    out = lax.map(expert_block, (buf.reshape(n_blocks, MOE_BLOCK, D), block_expert)).reshape(-1, D)
    y = jnp.einsum('tkd,tk->td', out[dest].reshape(T, TOP_K, D), gates)
    return y.reshape(B, S, D)


def setup_inputs(seed: int = 0) -> dict:
    key = jax.random.key(seed)
    ks = iter(jax.random.split(key, 48))
    D = D_MODEL

    def nrm(shape, scale):
        return jax.random.normal(next(ks), shape, jnp.float32) * scale

    def gain(shape):
        return 1.0 + nrm(shape, 0.02)

    return {
        "x": nrm((BATCH, SEQ, D), 1.0),
        "norm_mix": gain((DEPTH, D)),
        "norm_ffn": gain((DEPTH, D)),
        "norm_final": gain((D,)),
        "a_w_in": nrm((N_A_LAYERS, D, 2 * A_WIDTH), D ** -0.5),
        "a_ln_g": gain((N_A_LAYERS, A_WIDTH)),
        "a_ln_b": nrm((N_A_LAYERS, A_WIDTH), 0.02),
        "a_w_s": nrm((N_A_LAYERS, A_GROUPS, CHUNK, CHUNK), 0.5 * CHUNK ** -0.5),
        "a_b_s": 1.0 + nrm((N_A_LAYERS, A_GROUPS, CHUNK), 0.1),
        "a_w_out": nrm((N_A_LAYERS, A_WIDTH, D), A_WIDTH ** -0.5),
        "b_w_in": nrm((N_B_LAYERS, D, B_WIDTH), D ** -0.5),
        "b_w_grp": nrm((N_B_LAYERS, B_GROUPS, B_GROUP_DIM, B_GROUP_DIM), B_GROUP_DIM ** -0.5),
        "b_scale": 1.0 + nrm((N_B_LAYERS, B_WIDTH), 0.1),
        "b_w_out": nrm((N_B_LAYERS, B_WIDTH, D), B_WIDTH ** -0.5),
        "c_mu": jax.random.uniform(next(ks), (N_C_LAYERS, N_SHIFT, D), jnp.float32),
        "c_w_rkv": nrm((N_C_LAYERS, 3, D, D), D ** -0.5),
        "c_w0": jax.random.uniform(next(ks), (N_C_LAYERS, D), jnp.float32, minval=-5.0, maxval=-0.5),
        "c_w1": nrm((N_C_LAYERS, D, DECAY_LORA), D ** -0.5),
        "c_w2": nrm((N_C_LAYERS, DECAY_LORA, D), 0.1 * DECAY_LORA ** -0.5),
        "c_a0": nrm((N_C_LAYERS, D), 0.1),
        "c_a1": nrm((N_C_LAYERS, D, AAA_LORA), D ** -0.5),
        "c_a2": nrm((N_C_LAYERS, AAA_LORA, D), 0.3 * AAA_LORA ** -0.5),
        "c_g1": nrm((N_C_LAYERS, D, GATE_LORA), D ** -0.5),
        "c_g2": nrm((N_C_LAYERS, GATE_LORA, D), GATE_LORA ** -0.5),
        "c_k_k": 0.85 + nrm((N_C_LAYERS, D), 0.1),
        "c_k_a": 1.0 + nrm((N_C_LAYERS, D), 0.1),
        "c_r_k": nrm((N_C_LAYERS, C_HEADS, C_HEAD_DIM), 0.1),
        "c_ln_g": gain((N_C_LAYERS, D)),
        "c_ln_b": nrm((N_C_LAYERS, D), 0.02),
        "c_w_o": nrm((N_C_LAYERS, D, D), D ** -0.5),
        "f_w_gate": nrm((N_DENSE_LAYERS, D, D_FF), D ** -0.5),
        "f_w_up": nrm((N_DENSE_LAYERS, D, D_FF), D ** -0.5),
        "f_w_down": nrm((N_DENSE_LAYERS, D_FF, D), D_FF ** -0.5),
        "m_router": nrm((N_MOE_LAYERS, D, N_EXPERTS), D ** -0.5),
        "m_w_gate": nrm((N_MOE_LAYERS, N_EXPERTS, D, D_FF), D ** -0.5),
        "m_w_up": nrm((N_MOE_LAYERS, N_EXPERTS, D, D_FF), D ** -0.5),
        "m_w_down": nrm((N_MOE_LAYERS, N_EXPERTS, D_FF, D), D_FF ** -0.5),
    }


def reference(x, norm_mix, norm_ffn, norm_final,
              a_w_in, a_ln_g, a_ln_b, a_w_s, a_b_s, a_w_out,
              b_w_in, b_w_grp, b_scale, b_w_out,
              c_mu, c_w_rkv, c_w0, c_w1, c_w2, c_a0, c_a1, c_a2, c_g1, c_g2,
              c_k_k, c_k_a, c_r_k, c_ln_g, c_ln_b, c_w_o,
              f_w_gate, f_w_up, f_w_down,
              m_router, m_w_gate, m_w_up, m_w_down):
    for layer in range(DEPTH):
        h = rmsnorm(x, norm_mix[layer])
        kind, j = layer % N_MIXERS, layer // N_MIXERS
        if kind == 0:
            y = chunked_gmlp(h, a_w_in[j], a_ln_g[j], a_ln_b[j], a_w_s[j], a_b_s[j], a_w_out[j])
        elif kind == 1:
            y = pooling_mixer(h, b_w_in[j], b_w_grp[j], b_scale[j], b_w_out[j])
        else:
            y = rwkv7_time_mix(h, c_mu[j], c_w_rkv[j], c_w0[j], c_w1[j], c_w2[j],
                               c_a0[j], c_a1[j], c_a2[j], c_g1[j], c_g2[j],
                               c_k_k[j], c_k_a[j], c_r_k[j], c_ln_g[j], c_ln_b[j], c_w_o[j])
        x = x + y
        h = rmsnorm(x, norm_ffn[layer])
        j = layer // 2
        if layer % 2 == 0:
            y = swiglu(h, f_w_gate[j], f_w_up[j], f_w_down[j])
        else:
            y = moe_swiglu(h, m_router[j], m_w_gate[j], m_w_up[j], m_w_down[j])
        x = x + y
    return rmsnorm(x, norm_final)
```

```cpp
#include <hip/hip_runtime.h>
#include <stdint.h>
#include <stdio.h>

typedef unsigned short bf16;
typedef float f32x4 __attribute__((ext_vector_type(4)));
typedef float f32x2 __attribute__((ext_vector_type(2)));
typedef unsigned u32x4 __attribute__((ext_vector_type(4)));
typedef unsigned u32x2 __attribute__((ext_vector_type(2)));
#define LAS __attribute__((address_space(3)))

constexpr int T = 16384, D = 1024, FF = 3584, SEQ = 2048, NBATCH = 8, NE = 8, CAP = 16384;
constexpr int ACT_ROWS = 34816;
constexpr size_t MiB = 1u << 20;
constexpr size_t WS_CTL = 0, CTL_ZERO_BYTES = 1 * MiB;
constexpr size_t WS_VSTAT = 256 * 1024;
constexpr size_t WS_ROUTE = 1 * MiB;
constexpr size_t WS_WS = 2 * MiB, WS_WM = 82 * MiB, WS_XN = 252 * MiB, WS_BIG = 284 * MiB, WS_X2 = 804 * MiB, WS_END = 868 * MiB;
constexpr size_t RT_TOKE = 0, RT_TOKSLOT = 128 * 1024, RT_TOKGATE = 256 * 1024, RT_SLOTTOK = 384 * 1024;
constexpr size_t WA_IN = 0, WA_OUT = 4194304, WA_S = 6291456, WB_IN = 6553600, WB_GRP = 7602176, WB_OUT = 7864320, WC1 = 8912896, WC2 = 15728640, WC_O = 16515072,
                 WF_GU = 17563648, WF_D = 32243712;
constexpr size_t WC1L = WC1 + 3145728;
constexpr size_t MWGU_STRIDE = 7340032, MWD_OFF = 8 * 7340032, MWD_STRIDE = 3670016;
constexpr size_t B_ACT = 0, B_YK = 238 * MiB;
constexpr size_t B_U = 0, B_V = 32 * MiB, B_GATED = 64 * MiB, B_VPART = 96 * MiB;
constexpr size_t B_P = 0, B_DD = 64 * MiB, B_Y2 = 96 * MiB;
constexpr size_t B_XS = 306 * MiB;
constexpr size_t B_H2 = 0, B_R = 64 * MiB, B_K = 128 * MiB, B_VV = 192 * MiB, B_HID = 256 * MiB, B_DEC = 264 * MiB, B_AA = 328 * MiB, B_GG = 392 * MiB, B_Y = 424 * MiB, B_O = 488 * MiB;
constexpr int CW_TMO = 0, CW_BAR = 4096, CW_CNT = 8192;

enum { I_X = 0, I_NORM_MIX, I_NORM_FFN, I_NORM_FINAL, I_A_W_IN, I_A_LN_G, I_A_LN_B, I_A_W_S, I_A_B_S, I_A_W_OUT, I_B_W_IN, I_B_W_GRP, I_B_SCALE, I_B_W_OUT,
       I_C_MU, I_C_W_RKV, I_C_W0, I_C_W1, I_C_W2, I_C_A0, I_C_A1, I_C_A2, I_C_G1, I_C_G2, I_C_K_K, I_C_K_A, I_C_R_K, I_C_LN_G, I_C_LN_B, I_C_W_O,
       I_F_W_GATE, I_F_W_UP, I_F_W_DOWN, I_M_ROUTER, I_M_W_GATE, I_M_W_UP, I_M_W_DOWN, N_IN };

__device__ __forceinline__ unsigned f2bf(float f) { unsigned u = __float_as_uint(f); return (u + 0x7fffu + ((u >> 16) & 1u)) >> 16; }
__device__ __forceinline__ unsigned pk2(float lo, float hi) { return f2bf(lo) | (f2bf(hi) << 16); }
__device__ __forceinline__ float bflo(unsigned w) { return __uint_as_float(w << 16); }
__device__ __forceinline__ float bfhi(unsigned w) { return __uint_as_float(w & 0xffff0000u); }
__device__ __forceinline__ float bf2f(bf16 b) { return __uint_as_float(((unsigned)b) << 16); }
__device__ __forceinline__ float wave_sum(float v) {
#pragma unroll
    for (int o = 1; o < 64; o <<= 1) v += __shfl_xor(v, o);
    return v;
}
__device__ __forceinline__ float gelu_erf(float v) { return 0.5f * v * (1.0f + erff(v * 0.70710678118f)); }
__device__ __forceinline__ float sigmoidf_(float v) { return 1.0f / (1.0f + __expf(-v)); }
__device__ __forceinline__ float siluf_(float v) { return v / (1.0f + __expf(-v)); }
__device__ __forceinline__ float softplusf_(float z) { return fmaxf(z, 0.f) + log1pf(__expf(-fabsf(z))); }
__device__ __forceinline__ u32x4 pack8(const float (&y)[8]) { u32x4 w; w.x = pk2(y[0], y[1]); w.y = pk2(y[2], y[3]); w.z = pk2(y[4], y[5]); w.w = pk2(y[6], y[7]); return w; }
#define LDS_WAIT() asm volatile("s_waitcnt lgkmcnt(0)" ::: "memory")
__device__ __forceinline__ unsigned pk4_fp8(float a, float b, float c, float d) {
    a = __builtin_amdgcn_fmed3f(a, -448.f, 448.f); b = __builtin_amdgcn_fmed3f(b, -448.f, 448.f); c = __builtin_amdgcn_fmed3f(c, -448.f, 448.f); d = __builtin_amdgcn_fmed3f(d, -448.f, 448.f);
    int w = 0; w = __builtin_amdgcn_cvt_pk_fp8_f32(a, b, w, false); w = __builtin_amdgcn_cvt_pk_fp8_f32(c, d, w, true); return (unsigned)w;
}

__device__ __forceinline__ float fast_tanh(float x) { return 1.0f - 2.0f / (1.0f + __expf(2.0f * x)); }
__device__ __forceinline__ float fast_softplus(float z) { return fmaxf(z, 0.f) + __logf(1.0f + __expf(-fabsf(z))); }
__device__ __forceinline__ f32x2 gelu_pk(f32x2 v) {
    const f32x2 av = __builtin_elementwise_abs(v), d = av * 0.2316418882f + 1.0f;
    f32x2 t; t.x = __builtin_amdgcn_rcpf(d.x); t.y = __builtin_amdgcn_rcpf(d.y);
    f32x2 q = t * 0.5307027145f + (-0.7265760135f); q = q * t + 0.7107068705f; q = q * t + (-0.142248368f); q = q * t + 0.127414796f; q = q * t;
    const f32x2 s = (v * v) * (-0.72134752044f);
    f32x2 e; e.x = __builtin_amdgcn_exp2f(s.x); e.y = __builtin_amdgcn_exp2f(s.y);
    const f32x2 m = v * (q * e), r = v - m;
    f32x2 o; o.x = v.x < 0.f ? m.x : r.x; o.y = v.y < 0.f ? m.y : r.y; return o;
}
__device__ __forceinline__ void st8f(float* p, const float (&y)[8]) { ((f32x4*)p)[0] = (f32x4){y[0], y[1], y[2], y[3]}; ((f32x4*)p)[1] = (f32x4){y[4], y[5], y[6], y[7]}; }
struct EpiGeluUV {
    static constexpr int NKIND = 2;
    bf16* U; bf16* V; f32x2* vpart;
    __device__ __forceinline__ int kind(int col) const { return col < D ? 0 : 1; }
    template <int IMPL, int KIND> __device__ __forceinline__ void out8(int row, int col, const float (&v)[8]) const {
        const int kd = KIND >= 0 ? KIND : kind(col);
        float y[8];
#pragma unroll
        for (int i = 0; i < 8; i += 2) { const f32x2 g = gelu_pk((f32x2){v[i], v[i + 1]}); y[i] = g.x; y[i + 1] = g.y; }
        const u32x4 w = pack8(y);
        if (kd == 0) *(u32x4*)(U + (size_t)row * D + col) = w;
        else { *(u32x4*)(V + (size_t)row * D + (col - D)) = w; float s = 0.f, q = 0.f;
#pragma unroll
            for (int i = 0; i < 8; ++i) { s += y[i]; q += y[i] * y[i]; }
            if (IMPL == 0) { s += __shfl_xor(s, 1); q += __shfl_xor(q, 1); s += __shfl_xor(s, 2); q += __shfl_xor(q, 2); }
            else           { s += __shfl_xor(s, 16); q += __shfl_xor(q, 16); s += __shfl_xor(s, 32); q += __shfl_xor(q, 32); }
            if (((col - D) & 31) == 0) vpart[(size_t)row * 32 + ((col - D) >> 5)] = (f32x2){s, q}; }
    }
};
struct EpiResid {
    static constexpr int NKIND = 1;
    float* X; const float* S;
    __device__ __forceinline__ int kind(int) const { return 0; }
    template <int IMPL, int KIND> __device__ __forceinline__ void out8(int row, int col, const float (&v)[8]) const {
        const f32x4* q = (const f32x4*)(S + (size_t)row * D + col); f32x4* p = (f32x4*)(X + (size_t)row * D + col); f32x4 a = q[0], b = q[1];
        a += (f32x4){v[0], v[1], v[2], v[3]}; b += (f32x4){v[4], v[5], v[6], v[7]}; p[0] = a; p[1] = b;
    }
};
struct EpiSwiglu {
    static constexpr int NKIND = 1;
    bf16* ACT;
    __device__ __forceinline__ int kind(int) const { return 0; }
    template <int IMPL, int KIND> __device__ __forceinline__ void out8p(int orow, int fcol, const float (&g)[8], const float (&u)[8]) const {
        float y[8];
#pragma unroll
        for (int i = 0; i < 8; ++i) y[i] = siluf_(g[i]) * u[i];
        *(u32x4*)(ACT + (size_t)orow * FF + fcol) = pack8(y);
    }
};
struct EpiSwigluF8 {
    static constexpr int NKIND = 1;
    unsigned char* ACT; float sin, sout;
    __device__ __forceinline__ int kind(int) const { return 0; }
    template <int IMPL, int KIND> __device__ __forceinline__ void out8p(int orow, int fcol, const float (&g)[8], const float (&u)[8]) const {
        float y[8];
#pragma unroll
        for (int i = 0; i < 8; ++i) y[i] = siluf_(g[i] * sin) * (u[i] * sin) * sout;
        u32x2 w; w.x = pk4_fp8(y[0], y[1], y[2], y[3]); w.y = pk4_fp8(y[4], y[5], y[6], y[7]);
        *(u32x2*)(ACT + (size_t)orow * FF + fcol) = w;
    }
};
struct EpiMulBf16 {
    static constexpr int NKIND = 1;
    bf16* O; float mul;
    __device__ __forceinline__ int kind(int) const { return 0; }
    template <int IMPL, int KIND> __device__ __forceinline__ void out8(int row, int col, const float (&v)[8]) const {
        float y[8];
#pragma unroll
        for (int i = 0; i < 8; ++i) y[i] = v[i] * mul;
        *(u32x4*)(O + (size_t)row * D + col) = pack8(y);
    }
};
struct EpiF32 {
    static constexpr int NKIND = 1;
    float* P;
    __device__ __forceinline__ int kind(int) const { return 0; }
    template <int IMPL, int KIND> __device__ __forceinline__ void out8(int row, int col, const float (&v)[8]) const { st8f(P + (size_t)row * D + col, v); }
};
struct EpiScaleBf16 {
    static constexpr int NKIND = 1;
    bf16* O; const float* scale;
    __device__ __forceinline__ int kind(int) const { return 0; }
    template <int IMPL, int KIND> __device__ __forceinline__ void out8(int row, int col, const float (&v)[8]) const {
        float y[8];
#pragma unroll
        for (int i = 0; i < 8; ++i) y[i] = scale ? v[i] * scale[col + i] : v[i];
        *(u32x4*)(O + (size_t)row * D + col) = pack8(y);
    }
};
struct EpiC1 {
    static constexpr int NKIND = 2;
    bf16* R; bf16* HID;
    __device__ __forceinline__ int kind(int col) const { return col < 3 * D ? 0 : 1; }
    template <int IMPL, int KIND> __device__ __forceinline__ void out8(int row, int col, const float (&v)[8]) const {
        const int kd = KIND >= 0 ? KIND : kind(col);
        if (kd == 0) *(u32x4*)(R + (size_t)(col >> 10) * (size_t)(32 * MiB) + (size_t)row * D + (col & (D - 1))) = pack8(v);
        else { const int hc = col - 3 * D; float y[8];
#pragma unroll
            for (int i = 0; i < 8; ++i) y[i] = hc < 64 ? fast_tanh(v[i]) : (hc < 128 ? v[i] : sigmoidf_(v[i]));
            *(u32x4*)(HID + (size_t)row * 256 + hc) = pack8(y); }
    }
};
struct EpiC2 {
    static constexpr int NKIND = 3;
    float* DEC; bf16* AA; bf16* GG; const float* w0; const float* a0;
    __device__ __forceinline__ int kind(int col) const { return col >> 10; }
    template <int IMPL, int KIND> __device__ __forceinline__ void out8(int row, int col, const float (&v)[8]) const {
        const int kd = KIND >= 0 ? KIND : kind(col);
        const int c = col & (D - 1); float y[8];
        if (kd == 0) {
#pragma unroll
            for (int i = 0; i < 8; ++i) y[i] = __expf(-0.60653066f * sigmoidf_(w0[c + i] + v[i]));
            st8f(DEC + (size_t)row * D + c, y);
        } else if (kd == 1) {
#pragma unroll
            for (int i = 0; i < 8; ++i) y[i] = sigmoidf_(a0[c + i] + v[i]);
            *(u32x4*)(AA + (size_t)row * D + c) = pack8(y);
        } else {
#pragma unroll
            for (int i = 0; i < 8; ++i) y[i] = v[i];
            *(u32x4*)(GG + (size_t)row * D + c) = pack8(y);
        }
    }
};

namespace pg8 {
typedef short bf16x8 __attribute__((ext_vector_type(8)));
constexpr int BM = 256, BK = 64, HALF = 128, HTB = HALF * BK * 2, STAGE_BYTES = 8 * HTB, NXCD = 8, WGM = 8;
__host__ __device__ __forceinline__ int lds_byte(int r, int c) { const int st = (r >> 4) * 2 + (c >> 5), rr = r & 15, cc = c & 31, ob = rr * 64 + cc * 2; return st * 1024 + (ob ^ (((ob >> 9) & 1) << 5)); }
__host__ __device__ __forceinline__ void stage_rc(int b, int& R, int& C) { const int st = b / 1024, sb = b % 1024, swz = sb ^ (((sb >> 9) & 1) << 5); R = (st >> 1) * 16 + swz / 64; C = (st & 1) * 32 + (swz % 64) / 2; }
__host__ __device__ __forceinline__ int perm32(int rho) { const int n = rho >> 4, i = rho & 15; return 8 * (i >> 2) + 4 * n + (i & 3); }

struct Unit { const char* A; const char* B; int orow0, col0, e, mt; };
__device__ __forceinline__ const char* uniform_ptr(const char* p) {
    const unsigned long long v = (unsigned long long)p; const unsigned lo = (unsigned)__builtin_amdgcn_readfirstlane((int)(unsigned)v), hi = (unsigned)__builtin_amdgcn_readfirstlane((int)(unsigned)(v >> 32));
    return (const char*)(((unsigned long long)hi << 32) | lo); }
__device__ __forceinline__ bool tile_of(int i, int G, int c, int nM, int nN, int& pm, int& pn) {
    const int nwg = nM * nN; const long L = (long)i * G + c; if (L >= nwg) return false;
    int wgid = (int)L; { const int q = nwg / NXCD, r = nwg % NXCD, xcd = wgid % NXCD, off = wgid / NXCD; wgid = (xcd < r ? xcd * (q + 1) : r * (q + 1) + (xcd - r) * q) + off; }
    const int nig = WGM * nN, gid = wgid / nig, fm = gid * WGM, gsz = (nM - fm) < WGM ? (nM - fm) : WGM;
    pm = fm + ((wgid % nig) % gsz); pn = (wgid % nig) / gsz; return true;
}
struct PlainOrder {
    const bf16* A; const bf16* B; int lda, ldb, nM, nN, agrp, G, c, coff;
    __device__ __forceinline__ bool next(int i, Unit& u) const { int pm, pn; if (!tile_of(i, G, c, nM, nN, pm, pn)) return false;
        u.A = (const char*)(A + (size_t)pm * BM * lda + (agrp ? pn * BM : 0)); u.B = (const char*)(B + (size_t)pn * BM * ldb); u.orow0 = pm * BM; u.col0 = coff + pn * BM; u.e = 0; u.mt = 0; return true; }
    __device__ __forceinline__ int arow(const Unit&, int r) const { return r; }
};
struct C1Order {
    const bf16* XS; const bf16* B; int c;
    __device__ __forceinline__ bool next(int i, Unit& u) const { int real;
        if (c < 64) { if (i == 0) real = 384 + c; else if (i == 1) real = 640 + c; else return false; }
        else { if (i == 0) real = c - 64; else if (i == 1) real = 128 + c; else if (i == 2) real = 384 + c; else if (i == 3 && c < 128) real = 640 + c; else return false; }
        const int gid = real / 96, r = real - gid * 96, pm = gid * 8 + (r & 7), pn = r >> 3;
        u.A = (const char*)(XS + (size_t)(pn >> 2) * ((size_t)T * D) + (size_t)pm * BM * D); u.B = (const char*)(B + (size_t)pn * BM * D); u.orow0 = pm * BM; u.col0 = pn * BM; u.e = 0; u.mt = 0; return true; }
    __device__ __forceinline__ int arow(const Unit&, int r) const { return r; }
};
struct MoeOrder {
    const char* A; const char* B; size_t bstride; int lda, ldb, nN, G, c, gather, esz; const int* slotTok; int cnt[8], pfx[9];
    __device__ __forceinline__ void init(const unsigned* cntp) { int p = 0;
#pragma unroll
        for (int e = 0; e < 8; ++e) { cnt[e] = __builtin_amdgcn_readfirstlane((int)cntp[e]); pfx[e] = p; p += (cnt[e] + 255) >> 8; } pfx[8] = p; }
    __device__ __forceinline__ bool next(int i, Unit& u) const { int pm, pn; if (!tile_of(i, G, c, pfx[8], nN, pm, pn)) return false;
        int e = 0;
#pragma unroll
        for (int k = 1; k < 8; ++k) e += (pm >= pfx[k]) ? 1 : 0;
        int pe = 0;
#pragma unroll
        for (int k = 0; k < 8; ++k) pe = (k == e) ? pfx[k] : pe;
        u.e = e; u.mt = pm - pe; u.orow0 = pm * BM; u.col0 = pn * BM;
        u.A = gather ? A : A + (size_t)pm * BM * lda * esz; u.B = B + ((size_t)e * bstride + (size_t)pn * BM * ldb) * esz; return true; }
    __device__ __forceinline__ int arow(const Unit& u, int r) const { int ce = 0;
#pragma unroll
        for (int k = 0; k < 8; ++k) ce = (k == u.e) ? cnt[k] : ce;
        const int lr = u.mt * BM + r; return lr < ce ? slotTok[u.e * CAP + lr] : 0; }
};

template <class Epi, bool PAIR, int KIND>
__device__ __forceinline__ void run_epilogue_k(const Epi& E, const f32x4 (&acc)[2][2][4][2], const Unit& u, int wr, int wc, int fr, int fq) {
#pragma unroll
    for (int ai = 0; ai < 2; ++ai)
#pragma unroll
        for (int m = 0; m < 4; ++m) {
            const int orow = u.orow0 + ai * HALF + wr * 64 + m * 16 + fr;
            if constexpr (PAIR) {
                const f32x4 g0 = acc[ai][0][m][0], g1 = acc[ai][0][m][1], u0 = acc[ai][1][m][0], u1 = acc[ai][1][m][1];
                const float gv[8] = {g0[0], g0[1], g0[2], g0[3], g1[0], g1[1], g1[2], g1[3]}, uv[8] = {u0[0], u0[1], u0[2], u0[3], u1[0], u1[1], u1[2], u1[3]};
                E.template out8p<1, KIND>(orow, (u.col0 >> 1) + wc * 32 + 8 * fq, gv, uv);
            } else {
#pragma unroll
                for (int bj = 0; bj < 2; ++bj) { const f32x4 v0 = acc[ai][bj][m][0], v1 = acc[ai][bj][m][1];
                    const float v[8] = {v0[0], v0[1], v0[2], v0[3], v1[0], v1[1], v1[2], v1[3]};
                    E.template out8<1, KIND>(orow, u.col0 + bj * HALF + wc * 32 + 8 * fq, v); }
            }
        }
}
template <class Epi, bool PAIR>
__device__ __forceinline__ void run_epilogue(const Epi& E, const f32x4 (&acc)[2][2][4][2], const Unit& u, int wr, int wc, int fr, int fq) {
    if constexpr (Epi::NKIND == 1) run_epilogue_k<Epi, PAIR, 0>(E, acc, u, wr, wc, fr, fq);
    else { const int kd = E.kind(u.col0);
        if (kd == 0) run_epilogue_k<Epi, PAIR, 0>(E, acc, u, wr, wc, fr, fq);
        else if (Epi::NKIND == 2 || kd == 1) run_epilogue_k<Epi, PAIR, 1>(E, acc, u, wr, wc, fr, fq);
        else run_epilogue_k<Epi, PAIR, 2>(E, acc, u, wr, wc, fr, fq); }
}

typedef int i32x4 __attribute__((ext_vector_type(4)));
typedef int i32x8 __attribute__((ext_vector_type(8)));
template <class Epi, class Sched, bool PAIR, bool GATHER, bool ALIGN_EPI, bool FP8 = false>
__device__ __forceinline__ void gemm_phase(LAS unsigned char* lds, const int K, const int lda, const int ldb, const Sched& S, const Epi& E) {
    constexpr int ESZ = FP8 ? 1 : 2;
    int tid = threadIdx.x; asm volatile("" : "+v"(tid));
    const int wid = __builtin_amdgcn_readfirstlane(tid >> 6), lane = tid & 63, wr = wid >> 2, wc = wid & 3, fr = lane & 15, fq = lane >> 4;
    int Kv = K; asm volatile("" : "+s"(Kv));
    const int nt = Kv * ESZ / (BK * 2);
    unsigned voffB[2], vc[2][2], vn[2][2]; int RA[2], CA[2];
#pragma unroll
    for (int i = 0; i < 2; ++i) { int R, C; stage_rc(tid * 16 + i * 8192, R, C); const int Rb = (R & ~31) + perm32(R & 31); RA[i] = R; CA[i] = C; voffB[i] = (unsigned)(Rb * ldb * ESZ + C * 2); }
    const size_t kstep = (size_t)(BK * 2), hstepB = (size_t)HALF * ldb * ESZ;
    const unsigned ldsw = (unsigned)wid * 1024u;
    const int aoff = lds_byte(wr * 64 + fr, fq * 8), boff = lds_byte(wc * 32 + fr, fq * 8);
#define PG8_SA(b, h) (((b) * 2 + (h)) * HTB)
#define PG8_SB(b, h) ((4 + (b) * 2 + (h)) * HTB)
    const unsigned ldsbase = (unsigned)__builtin_amdgcn_readfirstlane((int)(unsigned)(size_t)lds) + ldsw;
#define PG8_GLDS(gbase, voff, ldsaddr) do { unsigned _keep; asm volatile("s_mov_b32 %0, m0\n\ts_mov_b32 m0, %3\n\ts_nop 0\n\tglobal_load_lds_dwordx4 %1, %2\n\ts_mov_b32 m0, %0" \
        : "=&s"(_keep) : "v"(voff), "s"(gbase), "s"(ldsaddr) : "memory"); } while (0)
#define PG8_STAGE_B(bufoff, gbase) do { _Pragma("unroll") for (int _i = 0; _i < 2; ++_i) PG8_GLDS((const char*)(gbase), voffB[_i], ldsbase + (unsigned)((bufoff) + _i * 8192)); } while (0)
#define PG8_STAGE_A(bufoff, gbase, vo, h) do { _Pragma("unroll") for (int _i = 0; _i < 2; ++_i) PG8_GLDS((const char*)(gbase), (vo)[h][_i], ldsbase + (unsigned)((bufoff) + _i * 8192)); } while (0)
#define PG8_LDA(dst, b, h) do { _Pragma("unroll") for (int m = 0; m < 4; ++m) _Pragma("unroll") for (int k = 0; k < 2; ++k) dst[m][k] = *(const LAS bf16x8*)(lds + PG8_SA(b, h) + aoff + m * 2048 + k * 1024); } while (0)
#define PG8_LDB(dst, b, h) do { _Pragma("unroll") for (int n = 0; n < 2; ++n) _Pragma("unroll") for (int k = 0; k < 2; ++k) dst[n][k] = *(const LAS bf16x8*)(lds + PG8_SB(b, h) + boff + n * 2048 + k * 1024); } while (0)
    const int f8scale = 0x7f7f7f7f;
#define PG8_MMA(ai, bj, At, Bt) do { __builtin_amdgcn_s_setprio(1); if constexpr (FP8) { _Pragma("unroll") for (int m = 0; m < 4; ++m) _Pragma("unroll") for (int n = 0; n < 2; ++n) { \
            const i32x8 _b8 = __builtin_shufflevector((i32x4)Bt[n][0], (i32x4)Bt[n][1], 0, 1, 2, 3, 4, 5, 6, 7), _a8 = __builtin_shufflevector((i32x4)At[m][0], (i32x4)At[m][1], 0, 1, 2, 3, 4, 5, 6, 7); \
            asm volatile("v_mfma_scale_f32_16x16x128_f8f6f4 %0, %1, %2, %0, %3, %3 op_sel_hi:[0,0,0]" : "+v"(acc[ai][bj][m][n]) : "v"(_b8), "v"(_a8), "v"(f8scale)); } } else { \
        _Pragma("unroll") for (int m = 0; m < 4; ++m) _Pragma("unroll") for (int n = 0; n < 2; ++n) _Pragma("unroll") for (int k = 0; k < 2; ++k) \
        acc[ai][bj][m][n] = __builtin_amdgcn_mfma_f32_16x16x32_bf16(Bt[n][k], At[m][k], acc[ai][bj][m][n], 0, 0, 0); } __builtin_amdgcn_s_setprio(0); } while (0)
#define PG8_WAIT_V(n) asm volatile("s_waitcnt vmcnt(" #n ")" ::: "memory")
#define PG8_WAIT_L(n) asm volatile("s_waitcnt lgkmcnt(" #n ")" ::: "memory")
#define PG8_BAR __builtin_amdgcn_s_barrier()
#define PG8_SCHED __builtin_amdgcn_sched_barrier(0)
#define PG8_VOFF(dst, un) do { _Pragma("unroll") for (int _h = 0; _h < 2; ++_h) _Pragma("unroll") for (int _i = 0; _i < 2; ++_i) \
        dst[_h][_i] = GATHER ? (unsigned)S.arow(un, _h * HALF + RA[_i]) * (unsigned)(lda * ESZ) + (unsigned)(CA[_i] * 2) : (unsigned)((_h * HALF + RA[_i]) * lda * ESZ + CA[_i] * 2); } while (0)
    Unit cur, nxt, nx2; int ui = 0; bool has_next = false; int ridx[2][2];
#define PG8_RIDX(un) do { _Pragma("unroll") for (int _h = 0; _h < 2; ++_h) _Pragma("unroll") for (int _i = 0; _i < 2; ++_i) ridx[_h][_i] = S.arow(un, _h * HALF + RA[_i]); } while (0)
    if (!S.next(0, cur)) return;
    PG8_VOFF(vc, cur);
    if constexpr (GATHER) { has_next = S.next(1, nxt); if (has_next) PG8_RIDX(nxt); }
    f32x4 acc[2][2][4][2];
#pragma unroll
    for (int a = 0; a < 2; ++a)
#pragma unroll
        for (int b = 0; b < 2; ++b)
#pragma unroll
            for (int m = 0; m < 4; ++m)
#pragma unroll
                for (int n = 0; n < 2; ++n) acc[a][b][m][n] = (f32x4){0.f, 0.f, 0.f, 0.f};
    bf16x8 At[4][2], B0[2][2], B1[2][2];
    const char* cA = uniform_ptr(cur.A); const char* cB = uniform_ptr(cur.B);
    if (GATHER) PG8_WAIT_V(0);
    PG8_STAGE_B(PG8_SB(0, 0), cB); PG8_STAGE_B(PG8_SB(0, 1), cB + hstepB); PG8_STAGE_A(PG8_SA(0, 0), cA, vc, 0); PG8_STAGE_A(PG8_SA(0, 1), cA, vc, 1);
    if (wr == 1) PG8_BAR;
    PG8_WAIT_V(2); PG8_BAR;
    PG8_STAGE_B(PG8_SB(1, 0), cB + kstep); PG8_STAGE_A(PG8_SA(1, 0), cA + kstep, vc, 0); PG8_STAGE_B(PG8_SB(1, 1), cB + hstepB + kstep);
    PG8_WAIT_V(6); PG8_BAR;
    for (;;) {
        if constexpr (!GATHER) has_next = S.next(ui + 1, nxt);
        const char* nA = has_next ? uniform_ptr(nxt.A) : cA; const char* nB = has_next ? uniform_ptr(nxt.B) : cB;
        bool has_nx2 = false;
        if constexpr (GATHER) {
#pragma unroll
            for (int h = 0; h < 2; ++h)
#pragma unroll
                for (int i = 0; i < 2; ++i) vn[h][i] = has_next ? (unsigned)ridx[h][i] * (unsigned)(lda * ESZ) + (unsigned)(CA[i] * 2) : vc[h][i];
            has_nx2 = has_next && S.next(ui + 2, nx2); if (has_nx2) PG8_RIDX(nx2); }
        for (int t = 0; t < nt; t += 2) {
            const bool last = (t == nt - 2);
            const char* a1 = cA + (size_t)(t + 1) * kstep;
            const char* a2 = last ? nA : cA + (size_t)(t + 2) * kstep; const char* b2 = last ? nB : cB + (size_t)(t + 2) * kstep;
            const char* a3 = a2 + kstep; const char* b3 = b2 + kstep;
            unsigned v2[2][2];
#pragma unroll
            for (int h = 0; h < 2; ++h) { v2[h][0] = (GATHER && last) ? vn[h][0] : vc[h][0]; v2[h][1] = (GATHER && last) ? vn[h][1] : vc[h][1]; }
            PG8_LDB(B0, 0, 0); PG8_LDB(B1, 0, 1); PG8_SCHED; PG8_LDA(At, 0, 0); PG8_STAGE_A(PG8_SA(1, 1), a1, vc, 1);
            PG8_WAIT_V(8); PG8_WAIT_L(0); PG8_BAR; PG8_MMA(0, 0, At, B0); PG8_MMA(0, 1, At, B1); PG8_BAR; PG8_SCHED;
            PG8_LDA(At, 0, 1); PG8_STAGE_B(PG8_SB(0, 0), b2); PG8_STAGE_B(PG8_SB(0, 1), b2 + hstepB); PG8_STAGE_A(PG8_SA(0, 0), a2, v2, 0);
            PG8_WAIT_V(8); PG8_WAIT_L(0); PG8_BAR; PG8_MMA(1, 0, At, B0); PG8_MMA(1, 1, At, B1); PG8_BAR; PG8_SCHED;
            PG8_LDB(B0, 1, 0); PG8_LDB(B1, 1, 1); PG8_SCHED; PG8_LDA(At, 1, 0); PG8_STAGE_A(PG8_SA(0, 1), a2, v2, 1);
            PG8_WAIT_V(8); PG8_WAIT_L(0); PG8_BAR; PG8_MMA(0, 0, At, B0); PG8_MMA(0, 1, At, B1); PG8_BAR; PG8_SCHED;
            PG8_LDA(At, 1, 1); PG8_STAGE_B(PG8_SB(1, 0), b3); PG8_STAGE_B(PG8_SB(1, 1), b3 + hstepB); PG8_STAGE_A(PG8_SA(1, 0), a3, v2, 0);
            PG8_WAIT_V(8); PG8_WAIT_L(0); PG8_BAR; PG8_MMA(1, 0, At, B0); PG8_MMA(1, 1, At, B1); PG8_BAR; PG8_SCHED;
        }
        if constexpr (ALIGN_EPI) { if (wr == 0) PG8_BAR; }
        if constexpr (FP8) asm volatile("s_nop 15\n\ts_nop 15" ::: "memory");
        { int frx = fr, fqx = fq; asm volatile("" : "+v"(frx), "+v"(fqx));
          run_epilogue<Epi, PAIR>(E, acc, cur, wr, wc, frx, fqx); }
        if (!has_next) break;
#pragma unroll
        for (int a = 0; a < 2; ++a)
#pragma unroll
            for (int b = 0; b < 2; ++b)
#pragma unroll
                for (int m = 0; m < 4; ++m)
#pragma unroll
                    for (int n = 0; n < 2; ++n) acc[a][b][m][n] = (f32x4){0.f, 0.f, 0.f, 0.f};
        cur = nxt; cA = nA; cB = nB; ++ui;
        if constexpr (GATHER) { nxt = nx2; has_next = has_nx2;
#pragma unroll
            for (int h = 0; h < 2; ++h) { vc[h][0] = vn[h][0]; vc[h][1] = vn[h][1]; } }
        if constexpr (ALIGN_EPI) { if (wr == 1) PG8_BAR; }
    }
    PG8_WAIT_V(0);
    if constexpr (!ALIGN_EPI) { if (wr == 0) PG8_BAR; }
    PG8_BAR;
#undef PG8_SA
#undef PG8_SB
#undef PG8_STAGE_A
#undef PG8_STAGE_B
#undef PG8_GLDS
#undef PG8_LDA
#undef PG8_LDB
#undef PG8_MMA
#undef PG8_WAIT_V
#undef PG8_WAIT_L
#undef PG8_BAR
#undef PG8_SCHED
#undef PG8_VOFF
#undef PG8_RIDX
}
}

#define XB_TMO      128
#define XB_XCNT(j)  (256  + 64 * (j))
#define XB_XSUB(j)  (1280 + 64 * (j))
#define XB_XGEN(j)  (2304 + 64 * (j))
#define XB_TOP      3328
#define XB_TOPGEN   3392
#define XCD_BAR_WORDS 3456
#define XB_SPIN_CAP (1u << 18)
__device__ __forceinline__ unsigned xb_ld(unsigned* p)              { return __hip_atomic_load(p, __ATOMIC_RELAXED, __HIP_MEMORY_SCOPE_AGENT); }
__device__ __forceinline__ unsigned xb_add(unsigned* p, unsigned v) { return __hip_atomic_fetch_add(p, v, __ATOMIC_RELAXED, __HIP_MEMORY_SCOPE_AGENT); }
__device__ __forceinline__ unsigned xb_xcc_id() { return (unsigned)__builtin_amdgcn_s_getreg((3 << 11) | 20) & 0xFu; }
#define XB_SPIN(cond, bar) do { unsigned _sp = 0; while (cond) { __builtin_amdgcn_s_sleep(1); \
    if ((++_sp & 255u) == 0u) { if (xb_ld(&(bar)[XB_TMO])) break; if (_sp > XB_SPIN_CAP) { atomicAdd(&(bar)[XB_TMO], 1u); break; } } } } while (0)
struct XcdBarrier { unsigned* bar; unsigned x; volatile LAS unsigned* st; };
__device__ __forceinline__ XcdBarrier xcd_barrier_post(unsigned* bar, volatile LAS unsigned* st) {
    XcdBarrier b; b.bar = bar; b.x = xb_xcc_id(); b.st = st;
    if (threadIdx.x == 0) (void)xb_add(&bar[XB_XCNT(b.x)], 1u);
    return b;
}
__device__ __forceinline__ void xcd_barrier_complete(unsigned* bar, unsigned x, unsigned& nloc, unsigned& nx) {
    const unsigned G = gridDim.x * gridDim.y * gridDim.z;
    unsigned sum, cnt, mine, sp = 0u;
    for (;;) {
        sum = 0u; cnt = 0u; mine = 0u;
#pragma unroll
        for (unsigned j = 0; j < 16; ++j) { const unsigned c = xb_ld(&bar[XB_XCNT(j)]); sum += c; cnt += (c > 0u) ? 1u : 0u; mine = (j == x) ? c : mine; }
        if (sum == G) break;
        __builtin_amdgcn_s_sleep(1);
        if ((++sp & 255u) == 0u) { if (xb_ld(&bar[XB_TMO])) break; if (sp > XB_SPIN_CAP) { atomicAdd(&bar[XB_TMO], 1u); break; } }
    }
    nloc = mine > 0u ? mine : 1u; nx = cnt > 0u ? cnt : 1u;
}
__device__ __forceinline__ void xcd_barrier(const XcdBarrier& b) {
    asm volatile("s_waitcnt vmcnt(0)" ::: "memory");
    __syncthreads();
    if (threadIdx.x == 0) {
        unsigned* bar = b.bar;
        __builtin_amdgcn_s_waitcnt(0);
        unsigned nloc = b.st[0], nx = b.st[1];
        if (nloc == 0u) { xcd_barrier_complete(bar, b.x, nloc, nx); b.st[0] = nloc; b.st[1] = nx; }
        const unsigned old = xb_add(&bar[XB_XSUB(b.x)], 1u);
        const unsigned gen = old / nloc;
        if (old + 1u == (gen + 1u) * nloc) {
            __builtin_amdgcn_fence(__ATOMIC_RELEASE, "agent");
            asm volatile("s_waitcnt vmcnt(0)" ::: "memory");
            const unsigned og = xb_add(&bar[XB_TOP], 1u);
            const unsigned tg = og / nx;
            if (og + 1u == (tg + 1u) * nx) xb_add(&bar[XB_TOPGEN], 1u);
            else XB_SPIN(xb_ld(&bar[XB_TOPGEN]) == tg, bar);
            __builtin_amdgcn_fence(__ATOMIC_ACQUIRE, "agent");
            xb_add(&bar[XB_XGEN(b.x)], 1u);
            asm volatile("s_waitcnt vmcnt(0)" ::: "memory");
        } else {
            XB_SPIN(xb_ld(&bar[XB_XGEN(b.x)]) == gen, bar);
            __builtin_amdgcn_fence(__ATOMIC_ACQUIRE, "agent");
            asm volatile("s_waitcnt vmcnt(0)" ::: "memory");
        }
    }
    __syncthreads();
}

constexpr int NWAVES = 8, NTHREADS = 512;
constexpr int LDS_BYTES = 147456;
constexpr int LDS_MISC = 147456 - 256;
struct Args { const float* in[N_IN]; float* out; unsigned char* ws; int ph_lo, ph_hi; };
struct Frame { LAS unsigned char* lds; int tid, lane, wave, gw, NGW; const Args* a; unsigned char* ws; float* X; bf16* XN; bf16* wsm; bf16* wmoe; unsigned* ctl; };

struct CvtCtx { int gw, NGW, lane, base; LAS float* scr; };
__device__ __forceinline__ void cvt_mat(CvtCtx& c, const float* W, int ldw, int K, int N, bf16* WT, int ldt, int drow0, int dcol0, const float* mu, int mumode, int pair, float f8scale = 0.f) {
    const int nnb = N / 64, nitems = (K / 64) * nnb, lane = c.lane;
    int start = c.gw - (c.base % c.NGW); if (start < 0) start += c.NGW;
    for (int it = start; it < nitems; it += c.NGW) {
        const int kb = it / nnb, nb = it - kb * nnb, k0 = kb * 64, n0 = nb * 64;
        const int drow = drow0 + (pair ? ((n0 >> 7) << 8) + (n0 & 127) + (pair == 2 ? 128 : 0) : n0);
        f32x4 v[16];
#pragma unroll
        for (int i = 0; i < 16; ++i) v[i] = *(const f32x4*)(W + (size_t)(k0 + 4 * i + (lane >> 4)) * ldw + n0 + (lane & 15) * 4);
#pragma unroll
        for (int i = 0; i < 16; ++i) {
            const int kk = 4 * i + (lane >> 4);
            if (mumode) { const float m = mu[k0 + kk]; const float sc = mumode == 1 ? 1.f - m : m; v[i] = v[i] * sc; }
            LAS float* p = c.scr + kk * 65 + (lane & 15) * 4; p[0] = v[i].x; p[1] = v[i].y; p[2] = v[i].z; p[3] = v[i].w;
        }
        LDS_WAIT();
        if (f8scale != 0.f) {
#pragma unroll
            for (int i = 0; i < 4; ++i) {
                const int n = 16 * i + (lane >> 2), cch = lane & 3; const LAS float* sp = c.scr + (16 * cch) * 65 + n;
                u32x4 o; o.x = pk4_fp8(sp[0] * f8scale, sp[65] * f8scale, sp[130] * f8scale, sp[195] * f8scale); o.y = pk4_fp8(sp[260] * f8scale, sp[325] * f8scale, sp[390] * f8scale, sp[455] * f8scale);
                o.z = pk4_fp8(sp[520] * f8scale, sp[585] * f8scale, sp[650] * f8scale, sp[715] * f8scale); o.w = pk4_fp8(sp[780] * f8scale, sp[845] * f8scale, sp[910] * f8scale, sp[975] * f8scale);
                *(u32x4*)((unsigned char*)WT + (size_t)(drow + n) * ldt + dcol0 + k0 + 16 * cch) = o;
            }
        } else {
#pragma unroll 4
        for (int i = 0; i < 8; ++i) {
            const int n = 8 * i + (lane >> 3), cch = lane & 7; const LAS float* s = c.scr + (8 * cch) * 65 + n;
            u32x4 o; o.x = pk2(s[0], s[65]); o.y = pk2(s[130], s[195]); o.z = pk2(s[260], s[325]); o.w = pk2(s[390], s[455]);
            *(u32x4*)(WT + (size_t)(drow + n) * ldt + dcol0 + k0 + 8 * cch) = o;
        }
        }
        LDS_WAIT();
    }
    c.base += nitems;
}
__device__ __forceinline__ void cvt_moe(Frame& F, CvtCtx& c, int layer, bool fp8) {
    const float* wg = F.a->in[I_M_W_GATE] + (size_t)layer * NE * D * FF; const float* wu = F.a->in[I_M_W_UP] + (size_t)layer * NE * D * FF;
    const float* wd = F.a->in[I_M_W_DOWN] + (size_t)layer * NE * D * FF;
    const float sc = fp8 ? 32.0f : 0.f; const int esz = fp8 ? 1 : 2;
    for (int e = 0; e < NE; ++e) {
        bf16* gu = (bf16*)((unsigned char*)F.wmoe + (size_t)e * MWGU_STRIDE * esz); bf16* dn = (bf16*)((unsigned char*)F.wmoe + (MWD_OFF + (size_t)e * MWD_STRIDE) * esz);
        cvt_mat(c, wg + (size_t)e * D * FF, FF, D, FF, gu, D, 0, 0, nullptr, 0, 1, sc);
        cvt_mat(c, wu + (size_t)e * D * FF, FF, D, FF, gu, D, 0, 0, nullptr, 0, 2, sc);
        cvt_mat(c, wd + (size_t)e * D * FF, D, FF, D, dn, FF, 0, 0, nullptr, 0, 0, sc);
    }
}

__device__ __forceinline__ void load_row(const float* xr, int lane, f32x4 (&v)[4]) {
#pragma unroll
    for (int j = 0; j < 4; ++j) v[j] = ((const f32x4*)xr)[lane + 64 * j];
}
__device__ __forceinline__ float row_rinv(const f32x4 (&v)[4]) {
    float s = 0.f;
#pragma unroll
    for (int j = 0; j < 4; ++j) s += (v[j].x * v[j].x + v[j].y * v[j].y) + (v[j].z * v[j].z + v[j].w * v[j].w);
    return rsqrtf(wave_sum(s) * (1.0f / D) + 1e-6f);
}
__device__ __forceinline__ void store_row_bf16(bf16* orow, int lane, const f32x4 (&v)[4]) {
#pragma unroll
    for (int j = 0; j < 4; ++j) { u32x2 w; w.x = pk2(v[j].x, v[j].y); w.y = pk2(v[j].z, v[j].w); ((u32x2*)orow)[lane + 64 * j] = w; }
}

__device__ __forceinline__ void ph_prologue(Frame& F) {
    const Args& a = *F.a;
    CvtCtx c; c.gw = F.gw; c.NGW = F.NGW; c.lane = F.lane; c.base = 0; c.scr = (LAS float*)(F.lds + F.wave * 16640);
    bf16* w = F.wsm;
    cvt_moe(F, c, 0, true);
    for (int l = 0; l < 2; ++l) {
        cvt_mat(c, a.in[I_A_W_IN] + (size_t)l * D * 2 * D, 2 * D, D, 2 * D, w + WA_IN + (size_t)l * 2 * D * D, D, 0, 0, nullptr, 0, 0);
        cvt_mat(c, a.in[I_A_W_OUT] + (size_t)l * D * D, D, D, D, w + WA_OUT + (size_t)l * D * D, D, 0, 0, nullptr, 0, 0);
        cvt_mat(c, a.in[I_F_W_GATE] + (size_t)l * D * FF, FF, D, FF, w + WF_GU + (size_t)l * 2 * FF * D, D, 0, 0, nullptr, 0, 1);
        cvt_mat(c, a.in[I_F_W_UP] + (size_t)l * D * FF, FF, D, FF, w + WF_GU + (size_t)l * 2 * FF * D, D, 0, 0, nullptr, 0, 2);
        cvt_mat(c, a.in[I_F_W_DOWN] + (size_t)l * D * FF, D, FF, D, w + WF_D + (size_t)l * D * FF, FF, 0, 0, nullptr, 0, 0);
    }
    cvt_mat(c, a.in[I_B_W_IN], D, D, D, w + WB_IN, D, 0, 0, nullptr, 0, 0);
    cvt_mat(c, a.in[I_B_W_OUT], D, D, D, w + WB_OUT, D, 0, 0, nullptr, 0, 0);
    for (int g = 0; g < 4; ++g) cvt_mat(c, a.in[I_B_W_GRP] + (size_t)g * 65536, 256, 256, 256, w + WB_GRP + (size_t)g * 65536, 256, 0, 0, nullptr, 0, 0);
    const float* mu = a.in[I_C_MU];
    for (int n = 0; n < 3; ++n) cvt_mat(c, a.in[I_C_W_RKV] + (size_t)n * D * D, D, D, D, w + WC1, D, n * D, 0, nullptr, 0, 0);
    cvt_mat(c, a.in[I_C_W1], 64, D, 64, w + WC1L, 2 * D, 0, 0, mu + 3 * D, 1, 0);
    cvt_mat(c, a.in[I_C_W1], 64, D, 64, w + WC1L, 2 * D, 0, D, mu + 3 * D, 2, 0);
    cvt_mat(c, a.in[I_C_A1], 64, D, 64, w + WC1L, 2 * D, 64, 0, mu + 4 * D, 1, 0);
    cvt_mat(c, a.in[I_C_A1], 64, D, 64, w + WC1L, 2 * D, 64, D, mu + 4 * D, 2, 0);
    cvt_mat(c, a.in[I_C_G1], 128, D, 128, w + WC1L, 2 * D, 128, 0, mu + 5 * D, 1, 0);
    cvt_mat(c, a.in[I_C_G1], 128, D, 128, w + WC1L, 2 * D, 128, D, mu + 5 * D, 2, 0);
    cvt_mat(c, a.in[I_C_W2], D, 64, D, w + WC2, 256, 0, 0, nullptr, 0, 0);
    cvt_mat(c, a.in[I_C_A2], D, 64, D, w + WC2, 256, D, 64, nullptr, 0, 0);
    cvt_mat(c, a.in[I_C_G2], D, 128, D, w + WC2, 256, 2 * D, 128, nullptr, 0, 0);
    cvt_mat(c, a.in[I_C_W_O], D, D, D, w + WC_O, D, 0, 0, nullptr, 0, 0);
    const int gt = F.gw * 64 + F.lane, NGT = F.NGW * 64;
    for (int i = gt; i < 3072 * 32; i += NGT) { const int r = i >> 5, q = i & 31, blk = r >> 10;
        const bool in = blk == 0 ? (q < 8) : (blk == 1 ? (q >= 8 && q < 16) : (q >= 16));
        if (!in) *(u32x4*)(w + WC2 + (size_t)r * 256 + q * 8) = (u32x4){0u, 0u, 0u, 0u}; }
    for (int i = gt; i < 2 * 8 * 128 * 128; i += NGT) { const int s = i & 127, t = (i >> 7) & 127; w[WA_S + i] = (bf16)(s <= t ? f2bf(a.in[I_A_W_S][i]) : 0u); }
    for (int m = F.gw; m < T; m += F.NGW) {
        f32x4 v[4]; load_row(a.in[I_X] + (size_t)m * D, F.lane, v);
        const float rinv = row_rinv(v);
#pragma unroll
        for (int j = 0; j < 4; ++j) v[j] = v[j] * rinv * ((const f32x4*)a.in[I_NORM_MIX])[F.lane + 64 * j];
        store_row_bf16(F.XN + (size_t)m * D, F.lane, v);
    }
}
__device__ __forceinline__ void ph_norm(Frame& F, const float* gain) {
    for (int m = F.gw; m < T; m += F.NGW) {
        f32x4 v[4]; load_row(F.X + (size_t)m * D, F.lane, v);
        const float rinv = row_rinv(v);
#pragma unroll
        for (int j = 0; j < 4; ++j) v[j] = v[j] * rinv * ((const f32x4*)gain)[F.lane + 64 * j];
        store_row_bf16(F.XN + (size_t)m * D, F.lane, v);
    }
}
__device__ __forceinline__ void ph_spatial(Frame& F, int l) {
    typedef short bf16x8 __attribute__((ext_vector_type(8)));
    const Args& a = *F.a;
    const bf16* U = (const bf16*)(F.ws + WS_BIG + B_U); const bf16* V = (const bf16*)(F.ws + WS_BIG + B_V); bf16* G = (bf16*)(F.ws + WS_BIG + B_GATED);
    const f32x2* vpart = (const f32x2*)(F.ws + WS_BIG + B_VPART);
    const float* lng = a.in[I_A_LN_G] + l * D; const float* lnb = a.in[I_A_LN_B] + l * D; const float* bs = a.in[I_A_B_S] + l * 8 * 128;
    const bf16* ws = F.wsm + WA_S + (size_t)l * 8 * 128 * 128;
    constexpr int RS = 272;
    LAS unsigned char* Wb = F.lds; LAS unsigned char* Vt = F.lds + 128 * RS; LAS float* stat = (LAS float*)(F.lds + 2 * 128 * RS);
    const int tid = F.tid, lane = F.lane, w = F.wave, fr = lane & 15, fq = lane >> 4;
    for (int u = blockIdx.x; u < 1024; u += gridDim.x) {
        const int g = u & 7, bc = u >> 3, t0 = bc * 128;
        __syncthreads();
        if (tid < 128) { float ps = 0.f, pq = 0.f; const f32x4* pp = (const f32x4*)(vpart + (size_t)(t0 + tid) * 32);
#pragma unroll
            for (int q = 0; q < 16; ++q) { const f32x4 x = pp[q]; ps += x.x + x.z; pq += x.y + x.w; }
            const float mean = ps * (1.0f / D), var = pq * (1.0f / D) - mean * mean; stat[tid * 2] = mean; stat[tid * 2 + 1] = rsqrtf(fmaxf(var, 0.f) + 1e-5f); }
        { const int t = tid >> 2, sc = (tid & 3) * 32;
#pragma unroll
          for (int q = 0; q < 4; ++q) *(LAS u32x4*)(Wb + t * RS + (sc + 8 * q) * 2) = *(const u32x4*)(ws + (size_t)g * 16384 + t * 128 + sc + 8 * q); }
        __syncthreads();
        { const int sidx = tid & 127, dq = tid >> 7; const float mean = stat[sidx * 2], rstd = stat[sidx * 2 + 1]; const size_t ro = (size_t)(t0 + sidx) * D + g * 128 + dq * 32;
          u32x4 wv[4];
#pragma unroll
          for (int q = 0; q < 4; ++q) wv[q] = *(const u32x4*)(V + ro + q * 8);
#pragma unroll
          for (int q = 0; q < 4; ++q) { const int c = g * 128 + dq * 32 + q * 8;
              const float x[8] = {bflo(wv[q].x), bfhi(wv[q].x), bflo(wv[q].y), bfhi(wv[q].y), bflo(wv[q].z), bfhi(wv[q].z), bflo(wv[q].w), bfhi(wv[q].w)};
#pragma unroll
              for (int i = 0; i < 8; ++i) *(LAS bf16*)(Vt + (dq * 32 + q * 8 + i) * RS + sidx * 2) = (bf16)f2bf((x[i] - mean) * rstd * lng[c + i] + lnb[c + i]); } }
        __syncthreads();
        const int dh = w >> 2;
#pragma unroll
        for (int half = 0; half < 2; ++half) {
            const int ti = half ? 7 - (w & 3) : (w & 3), nks = (ti >> 1) + 1;
            f32x4 acc[4];
#pragma unroll
            for (int j = 0; j < 4; ++j) acc[j] = (f32x4){0.f, 0.f, 0.f, 0.f};
            for (int ks = 0; ks < nks; ++ks) {
                const bf16x8 af = *(const LAS bf16x8*)(Wb + (16 * ti + fr) * RS + (32 * ks + 8 * fq) * 2);
#pragma unroll
                for (int j = 0; j < 4; ++j) { const bf16x8 bfv = *(const LAS bf16x8*)(Vt + (16 * (dh * 4 + j) + fr) * RS + (32 * ks + 8 * fq) * 2);
                    acc[j] = __builtin_amdgcn_mfma_f32_16x16x32_bf16(bfv, af, acc[j], 0, 0, 0); }
            }
            const int t = 16 * ti + fr; const float bias = bs[g * 128 + t];
#pragma unroll
            for (int j = 0; j < 4; ++j) { const size_t o = (size_t)(t0 + t) * D + g * 128 + 16 * (dh * 4 + j) + 4 * fq;
                const u32x2 uu = *(const u32x2*)(U + o); u32x2 r;
                r.x = pk2(bflo(uu.x) * (acc[j][0] + bias), bfhi(uu.x) * (acc[j][1] + bias)); r.y = pk2(bflo(uu.y) * (acc[j][2] + bias), bfhi(uu.y) * (acc[j][3] + bias));
                *(u32x2*)(G + o) = r; }
        }
    }
    __syncthreads();
}
template <int WIN> __device__ __forceinline__ void pool_row(const bf16* P, bf16* DD, int t, int c4) {
    const int pos = t & (SEQ - 1); u32x2 w[WIN];
#pragma unroll
    for (int k = 0; k < WIN; ++k) { const int tt = t - (k <= pos ? k : 0); w[k] = *(const u32x2*)(P + (size_t)tt * D + c4); }
    const f32x4 p0 = (f32x4){bflo(w[0].x), bfhi(w[0].x), bflo(w[0].y), bfhi(w[0].y)}; f32x4 s = p0;
#pragma unroll
    for (int k = 1; k < WIN; ++k) { const float m = k <= pos ? 1.0f : 0.0f; s += (f32x4){bflo(w[k].x), bfhi(w[k].x), bflo(w[k].y), bfhi(w[k].y)} * m; }
    const int cnt = (pos + 1) < WIN ? (pos + 1) : WIN;
    const f32x4 d = s * (1.0f / (float)cnt) - p0;
    u32x2 o; o.x = pk2(d.x, d.y); o.y = pk2(d.z, d.w); *(u32x2*)(DD + (size_t)t * D + c4) = o;
}
__device__ __forceinline__ void ph_pool(Frame& F) {
    const bf16* P = (const bf16*)(F.ws + WS_BIG + B_P); bf16* DD = (bf16*)(F.ws + WS_BIG + B_DD);
    for (int wi = F.gw; wi < T * 4; wi += F.NGW) {
        const int t = wi >> 2, g = wi & 3, c4 = g * 256 + F.lane * 4;
        if (g == 0) pool_row<2>(P, DD, t, c4); else if (g == 1) pool_row<4>(P, DD, t, c4); else if (g == 2) pool_row<8>(P, DD, t, c4); else pool_row<16>(P, DD, t, c4);
    }
}
__device__ __forceinline__ void ph_route(Frame& F, int layer, const float* gain, bool fp8out) {
    const Args& a = *F.a;
    const float* Rt = a.in[I_M_ROUTER] + (size_t)layer * D * NE;
    int* tokE = (int*)(F.ws + WS_ROUTE + RT_TOKE); int* tokSlot = (int*)(F.ws + WS_ROUTE + RT_TOKSLOT); float* tokGate = (float*)(F.ws + WS_ROUTE + RT_TOKGATE);
    int* slotTok = (int*)(F.ws + WS_ROUTE + RT_SLOTTOK); unsigned* cnt = F.ctl + CW_CNT + 64 * layer;
    LAS int* rowE = (LAS int*)F.lds;
    LAS int* rank = rowE + 128;
    LAS int* baseS = rank + 128;
    for (int blk = blockIdx.x; blk < T / 64; blk += gridDim.x) {
        __syncthreads();
        for (int r = F.wave; r < 64; r += NWAVES) {
            const int m = blk * 64 + r;
            f32x4 v[4]; load_row(F.X + (size_t)m * D, F.lane, v);
            const float rinv = row_rinv(v);
            float lg[8];
#pragma unroll
            for (int e = 0; e < 8; ++e) lg[e] = 0.f;
#pragma unroll
            for (int j = 0; j < 4; ++j) {
                v[j] = v[j] * rinv * ((const f32x4*)gain)[F.lane + 64 * j];
                const int d0 = 4 * F.lane + 256 * j;
#pragma unroll
                for (int i = 0; i < 4; ++i) { const f32x4 r0 = *(const f32x4*)(Rt + (size_t)(d0 + i) * 8), r1 = *(const f32x4*)(Rt + (size_t)(d0 + i) * 8 + 4); const float h = v[j][i];
                    lg[0] += h * r0.x; lg[1] += h * r0.y; lg[2] += h * r0.z; lg[3] += h * r0.w; lg[4] += h * r1.x; lg[5] += h * r1.y; lg[6] += h * r1.z; lg[7] += h * r1.w; }
            }
            if (fp8out) {
#pragma unroll
                for (int j = 0; j < 4; ++j) ((unsigned*)((unsigned char*)F.XN + (size_t)m * D))[F.lane + 64 * j] = pk4_fp8(v[j].x, v[j].y, v[j].z, v[j].w);
            } else store_row_bf16(F.XN + (size_t)m * D, F.lane, v);
#pragma unroll
            for (int e = 0; e < 8; ++e) lg[e] = wave_sum(lg[e]);
            int e0 = 0; float l0 = lg[0];
#pragma unroll
            for (int e = 1; e < 8; ++e) if (lg[e] > l0) { l0 = lg[e]; e0 = e; }
            int e1 = -1; float l1 = -3.0e38f;
#pragma unroll
            for (int e = 0; e < 8; ++e) if (e != e0 && lg[e] > l1) { l1 = lg[e]; e1 = e; }
            if (F.lane == 0) { const float g1 = 1.0f / (1.0f + __expf(l0 - l1)); rowE[r * 2] = e0; rowE[r * 2 + 1] = e1; tokGate[m * 2] = 1.0f - g1; tokGate[m * 2 + 1] = g1; tokE[m * 2] = e0; tokE[m * 2 + 1] = e1; }
        }
        __syncthreads();
        if (F.tid < 8) { int c = 0; for (int i = 0; i < 128; ++i) if (rowE[i] == F.tid) rank[i] = c++; baseS[F.tid] = c ? (int)atomicAdd(cnt + F.tid, (unsigned)c) : 0; }
        __syncthreads();
        if (F.tid < 128) { const int e = rowE[F.tid], slot = baseS[e] + rank[F.tid], m = blk * 64 + (F.tid >> 1); tokSlot[m * 2 + (F.tid & 1)] = slot; slotTok[e * CAP + slot] = m; }
    }
    __syncthreads();
}
struct CombineCtx { const int* tokE; const int* tokSlot; const float* tokGate; const bf16* YK; int pst[8]; };
__device__ __forceinline__ float combine_row(Frame& F, const CombineCtx& C, int m, f32x4 (&v)[4]) {
    const int e0 = C.tokE[m * 2], e1 = C.tokE[m * 2 + 1]; int p0 = 0, p1 = 0;
#pragma unroll
    for (int e = 0; e < 8; ++e) { p0 = e == e0 ? C.pst[e] : p0; p1 = e == e1 ? C.pst[e] : p1; }
    const size_t r0 = (size_t)(p0 + C.tokSlot[m * 2]) * D, r1 = (size_t)(p1 + C.tokSlot[m * 2 + 1]) * D; const float g0 = C.tokGate[m * 2], g1 = C.tokGate[m * 2 + 1];
    load_row(F.X + (size_t)m * D, F.lane, v);
#pragma unroll
    for (int j = 0; j < 4; ++j) { const u32x2 a = ((const u32x2*)(C.YK + r0))[F.lane + 64 * j], b = ((const u32x2*)(C.YK + r1))[F.lane + 64 * j];
        v[j].x += g0 * bflo(a.x) + g1 * bflo(b.x); v[j].y += g0 * bfhi(a.x) + g1 * bfhi(b.x); v[j].z += g0 * bflo(a.y) + g1 * bflo(b.y); v[j].w += g0 * bfhi(a.y) + g1 * bfhi(b.y); }
    return row_rinv(v);
}
__device__ __forceinline__ void ph_combine(Frame& F, int layer, const float* gain, int mode, float* Xo) {
    CombineCtx C; C.tokE = (const int*)(F.ws + WS_ROUTE + RT_TOKE); C.tokSlot = (const int*)(F.ws + WS_ROUTE + RT_TOKSLOT); C.tokGate = (const float*)(F.ws + WS_ROUTE + RT_TOKGATE);
    C.YK = (const bf16*)(F.ws + WS_BIG + B_YK);
    const unsigned* cnt = F.ctl + CW_CNT + 64 * layer; { int p = 0;
#pragma unroll
        for (int e = 0; e < 8; ++e) { C.pst[e] = p; p += ((int)cnt[e] + 255) & ~255; } }
    if (mode == 1) {
        bf16* H2 = (bf16*)(F.ws + WS_BIG + B_H2); bf16* XS = (bf16*)(F.ws + WS_BIG + B_XS); const float* mu = F.a->in[I_C_MU];
        for (int blk = F.gw; blk < T / 8; blk += F.NGW) {
            const int m0 = blk * 8; f32x4 hp[4];
            if ((m0 & (SEQ - 1)) == 0) {
#pragma unroll
                for (int j = 0; j < 4; ++j) hp[j] = (f32x4){0.f, 0.f, 0.f, 0.f};
            } else { const float rinv = combine_row(F, C, m0 - 1, hp);
#pragma unroll
                for (int j = 0; j < 4; ++j) hp[j] = hp[j] * rinv * ((const f32x4*)gain)[F.lane + 64 * j]; }
            for (int m = m0; m < m0 + 8; ++m) {
                f32x4 v[4]; const float rinv = combine_row(F, C, m, v);
#pragma unroll
                for (int j = 0; j < 4; ++j) { ((f32x4*)(Xo + (size_t)m * D))[F.lane + 64 * j] = v[j]; v[j] = v[j] * rinv * ((const f32x4*)gain)[F.lane + 64 * j]; }
                store_row_bf16(H2 + (size_t)m * 2 * D, F.lane, v); store_row_bf16(H2 + (size_t)m * 2 * D + D, F.lane, hp);
#pragma unroll
                for (int n = 0; n < 3; ++n) { f32x4 xs[4];
#pragma unroll
                    for (int j = 0; j < 4; ++j) { const f32x4 mm = ((const f32x4*)(mu + n * D))[F.lane + 64 * j]; xs[j] = v[j] + (hp[j] - v[j]) * mm; }
                    store_row_bf16(XS + (size_t)n * ((size_t)T * D) + (size_t)m * D, F.lane, xs); }
#pragma unroll
                for (int j = 0; j < 4; ++j) hp[j] = v[j];
            }
        }
        return;
    }
    for (int m = F.gw; m < T; m += F.NGW) {
        f32x4 v[4]; const float rinv = combine_row(F, C, m, v);
        if (mode == 0) {
#pragma unroll
            for (int j = 0; j < 4; ++j) ((f32x4*)(Xo + (size_t)m * D))[F.lane + 64 * j] = v[j];
        }
#pragma unroll
        for (int j = 0; j < 4; ++j) v[j] = v[j] * rinv * ((const f32x4*)gain)[F.lane + 64 * j];
        if (mode == 0) store_row_bf16(F.XN + (size_t)m * D, F.lane, v);
        else {
#pragma unroll
            for (int j = 0; j < 4; ++j) ((f32x4*)(Xo + (size_t)m * D))[F.lane + 64 * j] = v[j];
        }
    }
}
template <int CTRL> __device__ __forceinline__ float dppf(float v) { return __uint_as_float((unsigned)__builtin_amdgcn_update_dpp(0, (int)__float_as_uint(v), CTRL, 0xF, 0xF, true)); }
__device__ __forceinline__ float reduce16(float p) {
    p += dppf<0xB1>(p); p += dppf<0x4E>(p); p += dppf<0x141>(p); p += dppf<0x140>(p); return p;
}
__device__ __forceinline__ float vfma(float a, float b, float c) { float d = __builtin_fmaf(a, b, c); asm("" : "+v"(d)); return d; }
__device__ __forceinline__ float vmul(float a, float b) { float d = a * b; asm("" : "+v"(d)); return d; }
__device__ __forceinline__ f32x2 pkfma(f32x2 a, f32x2 b, f32x2 c) { f32x2 d = __builtin_elementwise_fma(a, b, c); asm("" : "+v"(d)); return d; }
__device__ __forceinline__ f32x2 pkmul(f32x2 a, f32x2 b) { f32x2 d = a * b; asm("" : "+v"(d)); return d; }
__device__ __forceinline__ float reduce8(float p) { p += dppf<0xB1>(p); p += dppf<0x4E>(p); p += dppf<0x141>(p); return p; }
__device__ __forceinline__ void ph_scan(Frame& F) {
    const Args& a = *F.a;
    const float* Rg = (const float*)(F.ws + WS_BIG + B_R); const float* Kg = (const float*)(F.ws + WS_BIG + B_K); const float* Vg = (const float*)(F.ws + WS_BIG + B_VV);
    const float* DEC = (const float*)(F.ws + WS_BIG + B_DEC); const float* AA = (const float*)(F.ws + WS_BIG + B_AA); float* Y = (float*)(F.ws + WS_BIG + B_Y);
    constexpr int VEC_F = 32 * 320, BUF_F = VEC_F + 1024, NCH = SEQ / 32;
    LAS float* sbase = (LAS float*)F.lds; LAS float* sY = sbase + 2 * BUF_F;
    const int lane = F.lane, w = F.wave;
    for (int u = blockIdx.x; u < 256; u += gridDim.x) {
        const int b = u >> 5, h = (u >> 1) & 15, half = u & 1, tb = b * SEQ;
        __syncthreads();
        if (w >= 4) {
            const int pwv = w - 4, col = h * 64 + lane, t2 = F.tid - 256;
            const float kkw = a.in[I_C_K_K][col], kaw = a.in[I_C_K_A][col];
            float pr[8], pw[8], pk[8], pa[8], pv[8];
            const __amdgpu_buffer_rsrc_t rs = __builtin_amdgcn_make_buffer_rsrc((void*)(F.ws + WS_BIG), 0, (int)(520 * MiB), 0x00020000);
            const int rbase = __builtin_amdgcn_readfirstlane(tb + pwv), cbase = __builtin_amdgcn_readfirstlane(h * 64);
            const int lo_flush = ((t2 >> 5) * D + (t2 & 31)) * 4, lane4 = lane * 4;
#define BLD(off) __uint_as_float(__builtin_amdgcn_raw_buffer_load_b32(rs, lane4, (off), 0))
#define BLH(off) __uint_as_float(((unsigned)__builtin_amdgcn_raw_buffer_load_b16(rs, lane4 >> 1, (off), 0)) << 16)
#define SCAN_LOAD(cc) do { int cco = (cc); asm volatile("" : "+s"(cco)); _Pragma("unroll") for (int q = 0; q < 8; ++q) { \
                const int ro = ((rbase + cco * 32 + 4 * q) * D + cbase) * 2; \
                pr[q] = BLH((int)B_R + ro); pw[q] = BLD((int)B_DEC + 2 * ro); pk[q] = BLH((int)B_K + ro); pa[q] = BLH((int)B_AA + ro); pv[q] = BLH((int)B_VV + ro); } } while (0)
#define SCAN_PREP(cc) do { LAS float* sbp = sbase + ((cc) & 1) * BUF_F + (lane >> 3) * 40 + (lane & 7); LAS float* svp = sbase + ((cc) & 1) * BUF_F + VEC_F + (lane & 31); _Pragma("unroll") for (int q = 0; q < 8; ++q) { \
                const int st = pwv + 4 * q; const float kk = pk[q] * kkw; float n2 = kk * kk; \
                n2 = reduce16(n2); n2 += __shfl_xor(n2, 16); n2 += __shfl_xor(n2, 32); \
                const float kkn = kk * __builtin_amdgcn_rsqf(fmaxf(n2, 1e-24f));   \
                LAS float* d = sbp + st * 320; \
                d[0] = -kkn; d[8] = pw[q]; d[16] = kkn * pa[q]; d[24] = pk[q] * (1.0f + (pa[q] - 1.0f) * kaw); d[32] = pr[q]; \
                if ((lane >> 5) == half) svp[st * 32] = pv[q]; } } while (0)
#define SCAN_FLUSH(cc) do { int cco = (cc); asm volatile("" : "+s"(cco)); const int yo = (int)B_Y + ((tb + cco * 32) * D + cbase + half * 32) * 2; _Pragma("unroll") for (int it = 0; it < 4; ++it) \
                __builtin_amdgcn_raw_buffer_store_b16((unsigned short)f2bf(sY[((cc) & 1) * 1024 + ((t2 >> 5) + 8 * it) * 32 + (t2 & 31)]), rs, lo_flush >> 1, yo + 8 * it * D * 2, 0); } while (0)
            SCAN_LOAD(0); SCAN_PREP(0); SCAN_LOAD(1);
            __syncthreads();
            for (int c = 0; c < NCH; ++c) {
                if (c + 1 < NCH) { SCAN_PREP(c + 1); if (c + 2 < NCH) SCAN_LOAD(c + 2); }
                if (c > 0) SCAN_FLUSH(c - 1);
                __syncthreads();
            }
            SCAN_FLUSH(NCH - 1);
#undef SCAN_LOAD
#undef SCAN_PREP
#undef SCAN_FLUSH
#undef BLD
#undef BLH
        } else {
            const int q8 = lane & 7, row = w * 8 + (lane >> 3);
            f32x2 S2[4];
#pragma unroll
            for (int i = 0; i < 4; ++i) S2[i] = (f32x2){0.f, 0.f};
            __syncthreads();
            for (int c = 0; c < NCH; ++c) {
                const LAS float* vp = sbase + (c & 1) * BUF_F + q8 * 40; const LAS float* sV = sbase + (c & 1) * BUF_F + VEC_F + row;
                f32x4 ca[2], cw[2], cb[2], ck[2], cr[2]; float vi = sV[0];
#pragma unroll
                for (int j = 0; j < 2; ++j) { ca[j] = *(const LAS f32x4*)(vp + 4 * j); cw[j] = *(const LAS f32x4*)(vp + 8 + 4 * j); cb[j] = *(const LAS f32x4*)(vp + 16 + 4 * j);
                    ck[j] = *(const LAS f32x4*)(vp + 24 + 4 * j); cr[j] = *(const LAS f32x4*)(vp + 32 + 4 * j); }
#pragma unroll 1
                for (int g8 = 0; g8 < 4; ++g8) {
                    float yacc = 0.f;
#pragma unroll
                    for (int s8 = 0; s8 < 8; ++s8) {
                        const int st = g8 * 8 + s8, sn = st < 31 ? st + 1 : 31;
                        f32x4 na[2], nw[2], nb[2], nk[2], nr[2];
#pragma unroll
                        for (int j = 0; j < 2; ++j) { na[j] = *(const LAS f32x4*)(vp + sn * 320 + 4 * j); nw[j] = *(const LAS f32x4*)(vp + sn * 320 + 8 + 4 * j); nb[j] = *(const LAS f32x4*)(vp + sn * 320 + 16 + 4 * j);
                            nk[j] = *(const LAS f32x4*)(vp + sn * 320 + 24 + 4 * j); nr[j] = *(const LAS f32x4*)(vp + sn * 320 + 32 + 4 * j); }
                        const float nv = sV[sn * 32];
                        __builtin_amdgcn_sched_barrier(0);
                        const f32x2 a01 = ca[0].xy, a23 = ca[0].zw, a45 = ca[1].xy, a67 = ca[1].zw, w01 = cw[0].xy, w23 = cw[0].zw, w45 = cw[1].xy, w67 = cw[1].zw;
                        const f32x2 b01 = cb[0].xy, b23 = cb[0].zw, b45 = cb[1].xy, b67 = cb[1].zw, k01 = ck[0].xy, k23 = ck[0].zw, k45 = ck[1].xy, k67 = ck[1].zw;
                        const f32x2 r01 = cr[0].xy, r23 = cr[0].zw, r45 = cr[1].xy, r67 = cr[1].zw;
                        f32x2 pp = pkmul(S2[0], a01), pq = pkmul(S2[2], a45); pp = pkfma(S2[1], a23, pp); pq = pkfma(S2[3], a67, pq);
                        const f32x2 vi2 = (f32x2){vi, vi};
                        f32x2 u0 = pkfma(S2[0], w01, pkmul(vi2, k01)), u1 = pkfma(S2[1], w23, pkmul(vi2, k23)), u2 = pkfma(S2[2], w45, pkmul(vi2, k45)), u3 = pkfma(S2[3], w67, pkmul(vi2, k67));
                        const f32x2 ps = pp + pq;
                        const float sa = reduce8(ps.x + ps.y);
                        const f32x2 sa2 = (f32x2){sa, sa};
                        S2[0] = pkfma(sa2, b01, u0); S2[1] = pkfma(sa2, b23, u1); S2[2] = pkfma(sa2, b45, u2); S2[3] = pkfma(sa2, b67, u3);
                        f32x2 yp = pkmul(S2[0], r01), yq = pkmul(S2[2], r45); yp = pkfma(S2[1], r23, yp); yq = pkfma(S2[3], r67, yq);
                        const f32x2 ys = yp + yq;
                        const float yv = reduce8(ys.x + ys.y);
                        yacc = (q8 == s8) ? yv : yacc;
#pragma unroll
                        for (int j = 0; j < 2; ++j) { ca[j] = na[j]; cw[j] = nw[j]; cb[j] = nb[j]; ck[j] = nk[j]; cr[j] = nr[j]; }
                        vi = nv;
                    }
                    sY[(c & 1) * 1024 + (g8 * 8 + q8) * 32 + row] = yacc;
                }
                __syncthreads();
            }
        }
    }
    __syncthreads();
}
__device__ __forceinline__ void ph_gnout(Frame& F) {
    const Args& a = *F.a;
    const bf16* Rg = (const bf16*)(F.ws + WS_BIG + B_R); const bf16* Kg = (const bf16*)(F.ws + WS_BIG + B_K); const bf16* Vg = (const bf16*)(F.ws + WS_BIG + B_VV);
    const bf16* AA = (const bf16*)(F.ws + WS_BIG + B_AA); const bf16* Y = (const bf16*)(F.ws + WS_BIG + B_Y); const bf16* GG = (const bf16*)(F.ws + WS_BIG + B_GG); bf16* O = (bf16*)(F.ws + WS_BIG + B_O);
    f32x4 lg[4], lb[4], ka[4], rk[4];
#pragma unroll
    for (int j = 0; j < 4; ++j) { lg[j] = ((const f32x4*)a.in[I_C_LN_G])[F.lane + 64 * j]; lb[j] = ((const f32x4*)a.in[I_C_LN_B])[F.lane + 64 * j];
        ka[j] = ((const f32x4*)a.in[I_C_K_A])[F.lane + 64 * j]; rk[j] = ((const f32x4*)a.in[I_C_R_K])[F.lane + 64 * j]; }
    for (int m = F.gw; m < T; m += F.NGW) {
        const size_t ro = (size_t)m * D;
        f32x4 y[4], r[4], k[4], aa[4], v[4]; u32x2 g[4];
#define LD4B(P) ({ const u32x2 _w = ((const u32x2*)((P) + ro))[F.lane + 64 * j]; (f32x4){bflo(_w.x), bfhi(_w.x), bflo(_w.y), bfhi(_w.y)}; })
#pragma unroll
        for (int j = 0; j < 4; ++j) { y[j] = LD4B(Y); r[j] = LD4B(Rg); k[j] = LD4B(Kg); aa[j] = LD4B(AA); v[j] = LD4B(Vg); g[j] = ((const u32x2*)(GG + ro))[F.lane + 64 * j]; }
#undef LD4B
#pragma unroll
        for (int j = 0; j < 4; ++j) {
            const float mean = reduce16((y[j].x + y[j].y) + (y[j].z + y[j].w)) * (1.0f / 64.0f);
            const f32x4 d = y[j] - mean;
            const float var = reduce16((d.x * d.x + d.y * d.y) + (d.z * d.z + d.w * d.w)) * (1.0f / 64.0f);
            const f32x4 yn = d * rsqrtf(var + 64e-5f) * lg[j] + lb[j];
            const f32x4 k2 = k[j] * ((aa[j] - 1.0f) * ka[j] + 1.0f), t = r[j] * k2 * rk[j];
            const float s = reduce16((t.x + t.y) + (t.z + t.w));
            const f32x4 o = yn + v[j] * s;
            u32x2 w; w.x = pk2(o.x * bflo(g[j].x), o.y * bfhi(g[j].x)); w.y = pk2(o.z * bflo(g[j].y), o.w * bfhi(g[j].y));
            ((u32x2*)(O + ro))[F.lane + 64 * j] = w;
        }
    }
}

enum { PH_PRO = 0, PH_A1_0, PH_SP_0, PH_A3_0, PH_NF_0, PH_F1_0, PH_F2_0, PH_NM_1, PH_B1, PH_POOL, PH_B2, PH_B3, PH_RT_0, PH_M1_0, PH_M2_0, PH_CB_0,
       PH_C1, PH_C2, PH_SCAN, PH_GN, PH_C5, PH_NF_2, PH_F1_1, PH_F2_1, PH_NM_3, PH_A1_1, PH_SP_1, PH_A3_1, PH_RT_1, PH_M1_1, PH_M2_1, PH_CB_1, N_PHASES };

__global__ void __launch_bounds__(NTHREADS, 2) fwd(Args args) {
    extern __shared__ __attribute__((aligned(16))) unsigned char lds_raw[];
    Frame F; F.lds = (LAS unsigned char*)lds_raw; F.tid = threadIdx.x; F.lane = F.tid & 63; F.wave = __builtin_amdgcn_readfirstlane(F.tid >> 6);
    F.gw = blockIdx.x * NWAVES + F.wave; F.NGW = gridDim.x * NWAVES; F.a = &args; F.ws = args.ws; F.X = args.out; F.XN = (bf16*)(args.ws + WS_XN);
    F.wsm = (bf16*)(args.ws + WS_WS); F.wmoe = (bf16*)(args.ws + WS_WM); F.ctl = (unsigned*)(args.ws + WS_CTL);
    volatile LAS unsigned* misc = (volatile LAS unsigned*)(F.lds + LDS_MISC);
    if (F.tid < 4) misc[F.tid] = 0u;
    __syncthreads();
    const int lo = args.ph_lo, hi = args.ph_hi;
    XcdBarrier bar; bar.bar = F.ctl + CW_BAR; bar.x = 0; bar.st = misc;
    if (hi - lo > 1) bar = xcd_barrier_post(F.ctl + CW_BAR, misc);
#define IN(k) (lo <= (k) && (k) < hi)
#define SEAM(k) do { if (IN(k) && IN((k) + 1)) xcd_barrier(bar); } while (0)
#ifndef REPEAT_MASK
#define REPEAT_MASK 0ull
#endif
#define PHASE(k, ...) do { if (IN(k)) { { __VA_ARGS__ } if ((REPEAT_MASK >> (k)) & 1ull) { xcd_barrier(bar); { __VA_ARGS__ } } } SEAM(k); } while (0)
    const float* nmix = args.in[I_NORM_MIX]; const float* nffn = args.in[I_NORM_FFN];
    unsigned char* big = F.ws + WS_BIG; const int G = (int)gridDim.x, cb = (int)blockIdx.x; float* X2 = (float*)(F.ws + WS_X2);
    if (lo > PH_CB_0) F.X = X2;
#define GPLAIN(EpiT, PAIRV, Ap, lda_, Bp, ldb_, N_, K_, agrp_, Eobj) do { pg8::PlainOrder S_{(const bf16*)(Ap), (const bf16*)(Bp), lda_, ldb_, T / 256, (N_) / 256, agrp_, G, cb, 0}; \
        pg8::gemm_phase<EpiT, pg8::PlainOrder, PAIRV, false, true>(F.lds, K_, lda_, ldb_, S_, Eobj); } while (0)
#define GMOE(EpiT, PAIRV, GATH, F8, Ap, lda_, Bp, bstr_, ldb_, nN_, K_, layer_, Eobj) do { pg8::MoeOrder S_; S_.A = (const char*)(Ap); S_.B = (const char*)(Bp); S_.bstride = bstr_; S_.lda = lda_; S_.ldb = ldb_; S_.nN = nN_; \
        S_.G = G; S_.c = cb; S_.gather = GATH; S_.esz = F8 ? 1 : 2; S_.slotTok = (const int*)(F.ws + WS_ROUTE + RT_SLOTTOK); S_.init(F.ctl + CW_CNT + 64 * (layer_)); \
        pg8::gemm_phase<EpiT, pg8::MoeOrder, PAIRV, GATH, true, F8>(F.lds, K_, lda_, ldb_, S_, Eobj); } while (0)
    PHASE(PH_PRO, ph_prologue(F););
    PHASE(PH_A1_0, EpiGeluUV E{(bf16*)(big + B_U), (bf16*)(big + B_V), (f32x2*)(big + B_VPART)}; GPLAIN(EpiGeluUV, false, F.XN, D, F.wsm + WA_IN, D, 2 * D, D, 0, E););
    PHASE(PH_SP_0, ph_spatial(F, 0););
    PHASE(PH_A3_0, EpiResid E{F.X, args.in[I_X]}; GPLAIN(EpiResid, false, big + B_GATED, D, F.wsm + WA_OUT, D, D, D, 0, E););
    PHASE(PH_NF_0, ph_norm(F, nffn + 0 * D););
    PHASE(PH_F1_0, EpiSwiglu E{(bf16*)(big + B_ACT)}; GPLAIN(EpiSwiglu, true, F.XN, D, F.wsm + WF_GU, D, 2 * FF, D, 0, E););
    PHASE(PH_F2_0, EpiResid E{F.X, F.X}; GPLAIN(EpiResid, false, big + B_ACT, FF, F.wsm + WF_D, FF, D, FF, 0, E););
    PHASE(PH_NM_1, ph_norm(F, nmix + 1 * D););
    PHASE(PH_B1, EpiScaleBf16 E{(bf16*)(big + B_P), nullptr}; GPLAIN(EpiScaleBf16, false, F.XN, D, F.wsm + WB_IN, D, D, D, 0, E););
    PHASE(PH_POOL, ph_pool(F););
    PHASE(PH_B2, EpiScaleBf16 E{(bf16*)(big + B_Y2), args.in[I_B_SCALE]}; GPLAIN(EpiScaleBf16, false, big + B_DD, D, F.wsm + WB_GRP, 256, D, 256, 1, E););
    PHASE(PH_B3, EpiResid E{F.X, F.X}; GPLAIN(EpiResid, false, big + B_Y2, D, F.wsm + WB_OUT, D, D, D, 0, E););
    PHASE(PH_RT_0, ph_route(F, 0, nffn + 1 * D, true););
    PHASE(PH_M1_0, EpiSwigluF8 E{(unsigned char*)(big + B_ACT), 1.0f / 32.0f, 8.0f}; GMOE(EpiSwigluF8, true, true, true, F.XN, D, F.wmoe, MWGU_STRIDE, D, 2 * FF / 256, D, 0, E););
    PHASE(PH_M2_0, EpiMulBf16 E{(bf16*)(big + B_YK), 1.0f / 256.0f}; GMOE(EpiMulBf16, false, false, true, big + B_ACT, FF, (unsigned char*)F.wmoe + MWD_OFF, MWD_STRIDE, FF, D / 256, FF, 0, E););
    PHASE(PH_CB_0, ph_combine(F, 0, nmix + 2 * D, 1, X2); CvtCtx c; c.gw = F.gw; c.NGW = F.NGW; c.lane = F.lane; c.base = 0; c.scr = (LAS float*)(F.lds + F.wave * 16640); cvt_moe(F, c, 1, true););
    F.X = X2;
    PHASE(PH_C1, EpiC1 E{(bf16*)(big + B_R), (bf16*)(big + B_HID)};
        { pg8::PlainOrder S_{(const bf16*)(big + B_H2), F.wsm + WC1L, 2 * D, 2 * D, T / 256, 1, 0, G, cb, 3 * D};
          pg8::gemm_phase<EpiC1, pg8::PlainOrder, false, false, true>(F.lds, 2 * D, 2 * D, 2 * D, S_, E); }
        { pg8::C1Order S_{(const bf16*)(big + B_XS), F.wsm + WC1, cb};
          pg8::gemm_phase<EpiC1, pg8::C1Order, false, false, true>(F.lds, D, D, D, S_, E); });
    PHASE(PH_C2, EpiC2 E{(float*)(big + B_DEC), (bf16*)(big + B_AA), (bf16*)(big + B_GG), args.in[I_C_W0], args.in[I_C_A0]}; GPLAIN(EpiC2, false, big + B_HID, 256, F.wsm + WC2, 256, 3072, 256, 0, E););
    PHASE(PH_SCAN, ph_scan(F););
    PHASE(PH_GN, ph_gnout(F););
    PHASE(PH_C5, EpiResid E{F.X, F.X}; GPLAIN(EpiResid, false, big + B_O, D, F.wsm + WC_O, D, D, D, 0, E););
    PHASE(PH_NF_2, ph_norm(F, nffn + 2 * D););
    PHASE(PH_F1_1, EpiSwiglu E{(bf16*)(big + B_ACT)}; GPLAIN(EpiSwiglu, true, F.XN, D, F.wsm + WF_GU + (size_t)2 * FF * D, D, 2 * FF, D, 0, E););
    PHASE(PH_F2_1, EpiResid E{F.X, F.X}; GPLAIN(EpiResid, false, big + B_ACT, FF, F.wsm + WF_D + (size_t)D * FF, FF, D, FF, 0, E););
    PHASE(PH_NM_3, ph_norm(F, nmix + 3 * D););
    PHASE(PH_A1_1, EpiGeluUV E{(bf16*)(big + B_U), (bf16*)(big + B_V), (f32x2*)(big + B_VPART)}; GPLAIN(EpiGeluUV, false, F.XN, D, F.wsm + WA_IN + (size_t)2 * D * D, D, 2 * D, D, 0, E););
    PHASE(PH_SP_1, ph_spatial(F, 1););
    PHASE(PH_A3_1, EpiResid E{F.X, F.X}; GPLAIN(EpiResid, false, big + B_GATED, D, F.wsm + WA_OUT + (size_t)D * D, D, D, D, 0, E););
    PHASE(PH_RT_1, ph_route(F, 1, nffn + 3 * D, true););
    PHASE(PH_M1_1, EpiSwigluF8 E{(unsigned char*)(big + B_ACT), 1.0f / 32.0f, 8.0f}; GMOE(EpiSwigluF8, true, true, true, F.XN, D, F.wmoe, MWGU_STRIDE, D, 2 * FF / 256, D, 1, E););
    PHASE(PH_M2_1, EpiMulBf16 E{(bf16*)(big + B_YK), 1.0f / 256.0f}; GMOE(EpiMulBf16, false, false, true, big + B_ACT, FF, (unsigned char*)F.wmoe + MWD_OFF, MWD_STRIDE, FF, D / 256, FF, 1, E););
    if (IN(PH_CB_1)) { ph_combine(F, 1, args.in[I_NORM_FINAL], 2, args.out); }
#undef GPLAIN
#undef GMOE
#undef IN
#undef SEAM
#undef PHASE
}

extern "C" void kernel_launch(void* const* d_in, const int* in_sizes, int n_in, void* d_out, int out_size, void* d_ws, size_t ws_size, hipStream_t stream) {
    static int grid = 0;
    if (grid == 0) {
        if (n_in != N_IN || out_size != T * D || ws_size < WS_END) { fprintf(stderr, "kernel_launch: unexpected shapes (n_in %d out %d ws %zu)\n", n_in, out_size, ws_size); grid = -1; return; }
        int dev = 0, cus = 0; hipGetDevice(&dev); hipDeviceGetAttribute(&cus, hipDeviceAttributeMultiprocessorCount, dev);
        if (hipFuncSetAttribute((const void*)fwd, hipFuncAttributeMaxDynamicSharedMemorySize, LDS_BYTES) != hipSuccess) { grid = -1; return; }
        grid = cus > 0 ? cus : 256;
    }
    if (grid < 0) return;
    hipMemsetAsync((char*)d_ws + WS_CTL, 0, CTL_ZERO_BYTES, stream);
    Args a{}; for (int i = 0; i < N_IN; ++i) a.in[i] = (const float*)d_in[i];
    a.out = (float*)d_out; a.ws = (unsigned char*)d_ws;
    auto thin = [&](int ph) { a.ph_lo = ph; a.ph_hi = ph + 1; hipLaunchKernelGGL(fwd, dim3(grid), dim3(NTHREADS), LDS_BYTES, stream, a); };
#ifndef ONE_LAUNCH
#define ONE_LAUNCH 1
#endif
    if (ONE_LAUNCH) { a.ph_lo = 0; a.ph_hi = N_PHASES; hipLaunchKernelGGL(fwd, dim3(grid), dim3(NTHREADS), LDS_BYTES, stream, a); return; }
    for (int ph = 0; ph < N_PHASES; ++ph) thin(ph);
}
```

```cpp
#include <hip/hip_runtime.h>
#include <stdint.h>
#include <stdio.h>

typedef unsigned short bf16;
typedef float f32x4 __attribute__((ext_vector_type(4)));
typedef float f32x2 __attribute__((ext_vector_type(2)));
typedef unsigned u32x4 __attribute__((ext_vector_type(4)));
typedef unsigned u32x2 __attribute__((ext_vector_type(2)));
#define LAS __attribute__((address_space(3)))

constexpr int T = 16384, D = 1024, FF = 3584, SEQ = 2048, NBATCH = 8, NE = 8, CAP = 16384;
constexpr int ACT_ROWS = 34816;
constexpr size_t MiB = 1u << 20;
constexpr size_t WS_CTL = 0, CTL_ZERO_BYTES = 1 * MiB;
constexpr size_t WS_VSTAT = 256 * 1024;
constexpr size_t WS_ROUTE = 1 * MiB;
constexpr size_t WS_WS = 2 * MiB, WS_WM = 82 * MiB, WS_XN = 252 * MiB, WS_BIG = 284 * MiB, WS_X2 = 804 * MiB, WS_END = 868 * MiB;
constexpr size_t RT_TOKE = 0, RT_TOKSLOT = 128 * 1024, RT_TOKGATE = 256 * 1024, RT_SLOTTOK = 384 * 1024;
constexpr size_t WA_IN = 0, WA_OUT = 4194304, WA_S = 6291456, WB_IN = 6553600, WB_GRP = 7602176, WB_OUT = 7864320, WC1 = 8912896, WC2 = 15728640, WC_O = 16515072,
                 WF_GU = 17563648, WF_D = 32243712;
constexpr size_t WC1L = WC1 + 3145728;
constexpr size_t MWGU_STRIDE = 7340032, MWD_OFF = 8 * 7340032, MWD_STRIDE = 3670016;
constexpr size_t B_ACT = 0, B_YK = 238 * MiB;
constexpr size_t B_U = 0, B_V = 32 * MiB, B_GATED = 64 * MiB, B_VPART = 96 * MiB;
constexpr size_t B_P = 0, B_DD = 64 * MiB, B_Y2 = 96 * MiB;
constexpr size_t B_XS = 306 * MiB;
constexpr size_t B_H2 = 0, B_R = 64 * MiB, B_K = 128 * MiB, B_VV = 192 * MiB, B_HID = 256 * MiB, B_DEC = 264 * MiB, B_AA = 328 * MiB, B_GG = 392 * MiB, B_Y = 424 * MiB, B_O = 488 * MiB;
constexpr int CW_TMO = 0, CW_BAR = 4096, CW_CNT = 8192;

enum { I_X = 0, I_NORM_MIX, I_NORM_FFN, I_NORM_FINAL, I_A_W_IN, I_A_LN_G, I_A_LN_B, I_A_W_S, I_A_B_S, I_A_W_OUT, I_B_W_IN, I_B_W_GRP, I_B_SCALE, I_B_W_OUT,
       I_C_MU, I_C_W_RKV, I_C_W0, I_C_W1, I_C_W2, I_C_A0, I_C_A1, I_C_A2, I_C_G1, I_C_G2, I_C_K_K, I_C_K_A, I_C_R_K, I_C_LN_G, I_C_LN_B, I_C_W_O,
       I_F_W_GATE, I_F_W_UP, I_F_W_DOWN, I_M_ROUTER, I_M_W_GATE, I_M_W_UP, I_M_W_DOWN, N_IN };

__device__ __forceinline__ unsigned f2bf(float f) { unsigned u = __float_as_uint(f); return (u + 0x7fffu + ((u >> 16) & 1u)) >> 16; }
__device__ __forceinline__ unsigned pk2(float lo, float hi) { return f2bf(lo) | (f2bf(hi) << 16); }
__device__ __forceinline__ float bflo(unsigned w) { return __uint_as_float(w << 16); }
__device__ __forceinline__ float bfhi(unsigned w) { return __uint_as_float(w & 0xffff0000u); }
__device__ __forceinline__ float bf2f(bf16 b) { return __uint_as_float(((unsigned)b) << 16); }
__device__ __forceinline__ float wave_sum(float v) {
#pragma unroll
    for (int o = 1; o < 64; o <<= 1) v += __shfl_xor(v, o);
    return v;
}
__device__ __forceinline__ float gelu_erf(float v) { return 0.5f * v * (1.0f + erff(v * 0.70710678118f)); }
__device__ __forceinline__ float sigmoidf_(float v) { return 1.0f / (1.0f + __expf(-v)); }
__device__ __forceinline__ float siluf_(float v) { return v / (1.0f + __expf(-v)); }
__device__ __forceinline__ float softplusf_(float z) { return fmaxf(z, 0.f) + log1pf(__expf(-fabsf(z))); }
__device__ __forceinline__ u32x4 pack8(const float (&y)[8]) { u32x4 w; w.x = pk2(y[0], y[1]); w.y = pk2(y[2], y[3]); w.z = pk2(y[4], y[5]); w.w = pk2(y[6], y[7]); return w; }
#define LDS_WAIT() asm volatile("s_waitcnt lgkmcnt(0)" ::: "memory")
__device__ __forceinline__ unsigned pk4_fp8(float a, float b, float c, float d) {
    a = __builtin_amdgcn_fmed3f(a, -448.f, 448.f); b = __builtin_amdgcn_fmed3f(b, -448.f, 448.f); c = __builtin_amdgcn_fmed3f(c, -448.f, 448.f); d = __builtin_amdgcn_fmed3f(d, -448.f, 448.f);
    int w = 0; w = __builtin_amdgcn_cvt_pk_fp8_f32(a, b, w, false); w = __builtin_amdgcn_cvt_pk_fp8_f32(c, d, w, true); return (unsigned)w;
}

__device__ __forceinline__ float fast_tanh(float x) { return 1.0f - 2.0f / (1.0f + __expf(2.0f * x)); }
__device__ __forceinline__ float fast_softplus(float z) { return fmaxf(z, 0.f) + __logf(1.0f + __expf(-fabsf(z))); }
__device__ __forceinline__ f32x2 gelu_pk(f32x2 v) {
    const f32x2 av = __builtin_elementwise_abs(v), d = av * 0.2316418882f + 1.0f;
    f32x2 t; t.x = __builtin_amdgcn_rcpf(d.x); t.y = __builtin_amdgcn_rcpf(d.y);
    f32x2 q = t * 0.5307027145f + (-0.7265760135f); q = q * t + 0.7107068705f; q = q * t + (-0.142248368f); q = q * t + 0.127414796f; q = q * t;
    const f32x2 s = (v * v) * (-0.72134752044f);
    f32x2 e; e.x = __builtin_amdgcn_exp2f(s.x); e.y = __builtin_amdgcn_exp2f(s.y);
    const f32x2 m = v * (q * e), r = v - m;
    f32x2 o; o.x = v.x < 0.f ? m.x : r.x; o.y = v.y < 0.f ? m.y : r.y; return o;
}
__device__ __forceinline__ void st8f(float* p, const float (&y)[8]) { ((f32x4*)p)[0] = (f32x4){y[0], y[1], y[2], y[3]}; ((f32x4*)p)[1] = (f32x4){y[4], y[5], y[6], y[7]}; }
struct EpiGeluUV {
    static constexpr int NKIND = 2;
    bf16* U; bf16* V; f32x2* vpart;
    __device__ __forceinline__ int kind(int col) const { return col < D ? 0 : 1; }
    template <int IMPL, int KIND> __device__ __forceinline__ void out8(int row, int col, const float (&v)[8]) const {
        const int kd = KIND >= 0 ? KIND : kind(col);
        float y[8];
#pragma unroll
        for (int i = 0; i < 8; i += 2) { const f32x2 g = gelu_pk((f32x2){v[i], v[i + 1]}); y[i] = g.x; y[i + 1] = g.y; }
        const u32x4 w = pack8(y);
        if (kd == 0) *(u32x4*)(U + (size_t)row * D + col) = w;
        else { *(u32x4*)(V + (size_t)row * D + (col - D)) = w; float s = 0.f, q = 0.f;
#pragma unroll
            for (int i = 0; i < 8; ++i) { s += y[i]; q += y[i] * y[i]; }
            if (IMPL == 0) { s += __shfl_xor(s, 1); q += __shfl_xor(q, 1); s += __shfl_xor(s, 2); q += __shfl_xor(q, 2); }
            else           { s += __shfl_xor(s, 16); q += __shfl_xor(q, 16); s += __shfl_xor(s, 32); q += __shfl_xor(q, 32); }
            if (((col - D) & 31) == 0) vpart[(size_t)row * 32 + ((col - D) >> 5)] = (f32x2){s, q}; }
    }
};
struct EpiResid {
    static constexpr int NKIND = 1;
    float* X; const float* S;
    __device__ __forceinline__ int kind(int) const { return 0; }
    template <int IMPL, int KIND> __device__ __forceinline__ void out8(int row, int col, const float (&v)[8]) const {
        const f32x4* q = (const f32x4*)(S + (size_t)row * D + col); f32x4* p = (f32x4*)(X + (size_t)row * D + col); f32x4 a = q[0], b = q[1];
        a += (f32x4){v[0], v[1], v[2], v[3]}; b += (f32x4){v[4], v[5], v[6], v[7]}; p[0] = a; p[1] = b;
    }
};
struct EpiSwiglu {
    static constexpr int NKIND = 1;
    bf16* ACT;
    __device__ __forceinline__ int kind(int) const { return 0; }
    template <int IMPL, int KIND> __device__ __forceinline__ void out8p(int orow, int fcol, const float (&g)[8], const float (&u)[8]) const {
        float y[8];
#pragma unroll
        for (int i = 0; i < 8; ++i) y[i] = siluf_(g[i]) * u[i];
        *(u32x4*)(ACT + (size_t)orow * FF + fcol) = pack8(y);
    }
};
struct EpiSwigluF8 {
    static constexpr int NKIND = 1;
    unsigned char* ACT; float sin, sout;
    __device__ __forceinline__ int kind(int) const { return 0; }
    template <int IMPL, int KIND> __device__ __forceinline__ void out8p(int orow, int fcol, const float (&g)[8], const float (&u)[8]) const {
        float y[8];
#pragma unroll
        for (int i = 0; i < 8; ++i) y[i] = siluf_(g[i] * sin) * (u[i] * sin) * sout;
        u32x2 w; w.x = pk4_fp8(y[0], y[1], y[2], y[3]); w.y = pk4_fp8(y[4], y[5], y[6], y[7]);
        *(u32x2*)(ACT + (size_t)orow * FF + fcol) = w;
    }
};
struct EpiMulBf16 {
    static constexpr int NKIND = 1;
    bf16* O; float mul;
    __device__ __forceinline__ int kind(int) const { return 0; }
    template <int IMPL, int KIND> __device__ __forceinline__ void out8(int row, int col, const float (&v)[8]) const {
        float y[8];
#pragma unroll
        for (int i = 0; i < 8; ++i) y[i] = v[i] * mul;
        *(u32x4*)(O + (size_t)row * D + col) = pack8(y);
    }
};
struct EpiF32 {
    static constexpr int NKIND = 1;
    float* P;
    __device__ __forceinline__ int kind(int) const { return 0; }
    template <int IMPL, int KIND> __device__ __forceinline__ void out8(int row, int col, const float (&v)[8]) const { st8f(P + (size_t)row * D + col, v); }
};
struct EpiScaleBf16 {
    static constexpr int NKIND = 1;
    bf16* O; const float* scale;
    __device__ __forceinline__ int kind(int) const { return 0; }
    template <int IMPL, int KIND> __device__ __forceinline__ void out8(int row, int col, const float (&v)[8]) const {
        float y[8];
#pragma unroll
        for (int i = 0; i < 8; ++i) y[i] = scale ? v[i] * scale[col + i] : v[i];
        *(u32x4*)(O + (size_t)row * D + col) = pack8(y);
    }
};
struct EpiC1 {
    static constexpr int NKIND = 2;
    bf16* R; bf16* HID;
    __device__ __forceinline__ int kind(int col) const { return col < 3 * D ? 0 : 1; }
    template <int IMPL, int KIND> __device__ __forceinline__ void out8(int row, int col, const float (&v)[8]) const {
        const int kd = KIND >= 0 ? KIND : kind(col);
        if (kd == 0) *(u32x4*)(R + (size_t)(col >> 10) * (size_t)(32 * MiB) + (size_t)row * D + (col & (D - 1))) = pack8(v);
        else { const int hc = col - 3 * D; float y[8];
#pragma unroll
            for (int i = 0; i < 8; ++i) y[i] = hc < 64 ? fast_tanh(v[i]) : (hc < 128 ? v[i] : sigmoidf_(v[i]));
            *(u32x4*)(HID + (size_t)row * 256 + hc) = pack8(y); }
    }
};
struct EpiC2 {
    static constexpr int NKIND = 3;
    float* DEC; bf16* AA; bf16* GG; const float* w0; const float* a0;
    __device__ __forceinline__ int kind(int col) const { return col >> 10; }
    template <int IMPL, int KIND> __device__ __forceinline__ void out8(int row, int col, const float (&v)[8]) const {
        const int kd = KIND >= 0 ? KIND : kind(col);
        const int c = col & (D - 1); float y[8];
        if (kd == 0) {
#pragma unroll
            for (int i = 0; i < 8; ++i) y[i] = __expf(-0.60653066f * sigmoidf_(w0[c + i] + v[i]));
            st8f(DEC + (size_t)row * D + c, y);
        } else if (kd == 1) {
#pragma unroll
            for (int i = 0; i < 8; ++i) y[i] = sigmoidf_(a0[c + i] + v[i]);
            *(u32x4*)(AA + (size_t)row * D + c) = pack8(y);
        } else {
#pragma unroll
            for (int i = 0; i < 8; ++i) y[i] = v[i];
            *(u32x4*)(GG + (size_t)row * D + c) = pack8(y);
        }
    }
};

namespace pg8 {
typedef short bf16x8 __attribute__((ext_vector_type(8)));
constexpr int BM = 256, BK = 64, HALF = 128, HTB = HALF * BK * 2, STAGE_BYTES = 8 * HTB, NXCD = 8, WGM = 8;
__host__ __device__ __forceinline__ int lds_byte(int r, int c) { const int st = (r >> 4) * 2 + (c >> 5), rr = r & 15, cc = c & 31, ob = rr * 64 + cc * 2; return st * 1024 + (ob ^ (((ob >> 9) & 1) << 5)); }
__host__ __device__ __forceinline__ void stage_rc(int b, int& R, int& C) { const int st = b / 1024, sb = b % 1024, swz = sb ^ (((sb >> 9) & 1) << 5); R = (st >> 1) * 16 + swz / 64; C = (st & 1) * 32 + (swz % 64) / 2; }
__host__ __device__ __forceinline__ int perm32(int rho) { const int n = rho >> 4, i = rho & 15; return 8 * (i >> 2) + 4 * n + (i & 3); }

struct Unit { const char* A; const char* B; int orow0, col0, e, mt; };
__device__ __forceinline__ const char* uniform_ptr(const char* p) {
    const unsigned long long v = (unsigned long long)p; const unsigned lo = (unsigned)__builtin_amdgcn_readfirstlane((int)(unsigned)v), hi = (unsigned)__builtin_amdgcn_readfirstlane((int)(unsigned)(v >> 32));
    return (const char*)(((unsigned long long)hi << 32) | lo); }
__device__ __forceinline__ bool tile_of(int i, int G, int c, int nM, int nN, int& pm, int& pn) {
    const int nwg = nM * nN; const long L = (long)i * G + c; if (L >= nwg) return false;
    int wgid = (int)L; { const int q = nwg / NXCD, r = nwg % NXCD, xcd = wgid % NXCD, off = wgid / NXCD; wgid = (xcd < r ? xcd * (q + 1) : r * (q + 1) + (xcd - r) * q) + off; }
    const int nig = WGM * nN, gid = wgid / nig, fm = gid * WGM, gsz = (nM - fm) < WGM ? (nM - fm) : WGM;
    pm = fm + ((wgid % nig) % gsz); pn = (wgid % nig) / gsz; return true;
}
struct PlainOrder {
    const bf16* A; const bf16* B; int lda, ldb, nM, nN, agrp, G, c, coff;
    __device__ __forceinline__ bool next(int i, Unit& u) const { int pm, pn; if (!tile_of(i, G, c, nM, nN, pm, pn)) return false;
        u.A = (const char*)(A + (size_t)pm * BM * lda + (agrp ? pn * BM : 0)); u.B = (const char*)(B + (size_t)pn * BM * ldb); u.orow0 = pm * BM; u.col0 = coff + pn * BM; u.e = 0; u.mt = 0; return true; }
    __device__ __forceinline__ int arow(const Unit&, int r) const { return r; }
};
struct C1Order {
    const bf16* XS; const bf16* B; int c;
    __device__ __forceinline__ bool next(int i, Unit& u) const { int real;
        if (c < 64) { if (i == 0) real = 384 + c; else if (i == 1) real = 640 + c; else return false; }
        else { if (i == 0) real = c - 64; else if (i == 1) real = 128 + c; else if (i == 2) real = 384 + c; else if (i == 3 && c < 128) real = 640 + c; else return false; }
        const int gid = real / 96, r = real - gid * 96, pm = gid * 8 + (r & 7), pn = r >> 3;
        u.A = (const char*)(XS + (size_t)(pn >> 2) * ((size_t)T * D) + (size_t)pm * BM * D); u.B = (const char*)(B + (size_t)pn * BM * D); u.orow0 = pm * BM; u.col0 = pn * BM; u.e = 0; u.mt = 0; return true; }
    __device__ __forceinline__ int arow(const Unit&, int r) const { return r; }
};
struct MoeOrder {
    const char* A; const char* B; size_t bstride; int lda, ldb, nN, G, c, gather, esz; const int* slotTok; int cnt[8], pfx[9];
    __device__ __forceinline__ void init(const unsigned* cntp) { int p = 0;
#pragma unroll
        for (int e = 0; e < 8; ++e) { cnt[e] = __builtin_amdgcn_readfirstlane((int)cntp[e]); pfx[e] = p; p += (cnt[e] + 255) >> 8; } pfx[8] = p; }
    __device__ __forceinline__ bool next(int i, Unit& u) const { int pm, pn; if (!tile_of(i, G, c, pfx[8], nN, pm, pn)) return false;
        int e = 0;
#pragma unroll
        for (int k = 1; k < 8; ++k) e += (pm >= pfx[k]) ? 1 : 0;
        int pe = 0;
#pragma unroll
        for (int k = 0; k < 8; ++k) pe = (k == e) ? pfx[k] : pe;
        u.e = e; u.mt = pm - pe; u.orow0 = pm * BM; u.col0 = pn * BM;
        u.A = gather ? A : A + (size_t)pm * BM * lda * esz; u.B = B + ((size_t)e * bstride + (size_t)pn * BM * ldb) * esz; return true; }
    __device__ __forceinline__ int arow(const Unit& u, int r) const { int ce = 0;
#pragma unroll
        for (int k = 0; k < 8; ++k) ce = (k == u.e) ? cnt[k] : ce;
        const int lr = u.mt * BM + r; return lr < ce ? slotTok[u.e * CAP + lr] : 0; }
};

template <class Epi, bool PAIR, int KIND>
__device__ __forceinline__ void run_epilogue_k(const Epi& E, const f32x4 (&acc)[2][2][4][2], const Unit& u, int wr, int wc, int fr, int fq) {
#pragma unroll
    for (int ai = 0; ai < 2; ++ai)
#pragma unroll
        for (int m = 0; m < 4; ++m) {
            const int orow = u.orow0 + ai * HALF + wr * 64 + m * 16 + fr;
            if constexpr (PAIR) {
                const f32x4 g0 = acc[ai][0][m][0], g1 = acc[ai][0][m][1], u0 = acc[ai][1][m][0], u1 = acc[ai][1][m][1];
                const float gv[8] = {g0[0], g0[1], g0[2], g0[3], g1[0], g1[1], g1[2], g1[3]}, uv[8] = {u0[0], u0[1], u0[2], u0[3], u1[0], u1[1], u1[2], u1[3]};
                E.template out8p<1, KIND>(orow, (u.col0 >> 1) + wc * 32 + 8 * fq, gv, uv);
            } else {
#pragma unroll
                for (int bj = 0; bj < 2; ++bj) { const f32x4 v0 = acc[ai][bj][m][0], v1 = acc[ai][bj][m][1];
                    const float v[8] = {v0[0], v0[1], v0[2], v0[3], v1[0], v1[1], v1[2], v1[3]};
                    E.template out8<1, KIND>(orow, u.col0 + bj * HALF + wc * 32 + 8 * fq, v); }
            }
        }
}
template <class Epi, bool PAIR>
__device__ __forceinline__ void run_epilogue(const Epi& E, const f32x4 (&acc)[2][2][4][2], const Unit& u, int wr, int wc, int fr, int fq) {
    if constexpr (Epi::NKIND == 1) run_epilogue_k<Epi, PAIR, 0>(E, acc, u, wr, wc, fr, fq);
    else { const int kd = E.kind(u.col0);
        if (kd == 0) run_epilogue_k<Epi, PAIR, 0>(E, acc, u, wr, wc, fr, fq);
        else if (Epi::NKIND == 2 || kd == 1) run_epilogue_k<Epi, PAIR, 1>(E, acc, u, wr, wc, fr, fq);
        else run_epilogue_k<Epi, PAIR, 2>(E, acc, u, wr, wc, fr, fq); }
}

typedef int i32x4 __attribute__((ext_vector_type(4)));
typedef int i32x8 __attribute__((ext_vector_type(8)));
template <class Epi, class Sched, bool PAIR, bool GATHER, bool ALIGN_EPI, bool FP8 = false>
__device__ __forceinline__ void gemm_phase(LAS unsigned char* lds, const int K, const int lda, const int ldb, const Sched& S, const Epi& E) {
    constexpr int ESZ = FP8 ? 1 : 2;
    int tid = threadIdx.x; asm volatile("" : "+v"(tid));
    const int wid = __builtin_amdgcn_readfirstlane(tid >> 6), lane = tid & 63, wr = wid >> 2, wc = wid & 3, fr = lane & 15, fq = lane >> 4;
    int Kv = K; asm volatile("" : "+s"(Kv));
    const int nt = Kv * ESZ / (BK * 2);
    unsigned voffB[2], vc[2][2], vn[2][2]; int RA[2], CA[2];
#pragma unroll
    for (int i = 0; i < 2; ++i) { int R, C; stage_rc(tid * 16 + i * 8192, R, C); const int Rb = (R & ~31) + perm32(R & 31); RA[i] = R; CA[i] = C; voffB[i] = (unsigned)(Rb * ldb * ESZ + C * 2); }
    const size_t kstep = (size_t)(BK * 2), hstepB = (size_t)HALF * ldb * ESZ;
    const unsigned ldsw = (unsigned)wid * 1024u;
    const int aoff = lds_byte(wr * 64 + fr, fq * 8), boff = lds_byte(wc * 32 + fr, fq * 8);
#define PG8_SA(b, h) (((b) * 2 + (h)) * HTB)
#define PG8_SB(b, h) ((4 + (b) * 2 + (h)) * HTB)
    const unsigned ldsbase = (unsigned)__builtin_amdgcn_readfirstlane((int)(unsigned)(size_t)lds) + ldsw;
#define PG8_GLDS(gbase, voff, ldsaddr) do { unsigned _keep; asm volatile("s_mov_b32 %0, m0\n\ts_mov_b32 m0, %3\n\ts_nop 0\n\tglobal_load_lds_dwordx4 %1, %2\n\ts_mov_b32 m0, %0" \
        : "=&s"(_keep) : "v"(voff), "s"(gbase), "s"(ldsaddr) : "memory"); } while (0)
#define PG8_STAGE_B(bufoff, gbase) do { _Pragma("unroll") for (int _i = 0; _i < 2; ++_i) PG8_GLDS((const char*)(gbase), voffB[_i], ldsbase + (unsigned)((bufoff) + _i * 8192)); } while (0)
#define PG8_STAGE_A(bufoff, gbase, vo, h) do { _Pragma("unroll") for (int _i = 0; _i < 2; ++_i) PG8_GLDS((const char*)(gbase), (vo)[h][_i], ldsbase + (unsigned)((bufoff) + _i * 8192)); } while (0)
#define PG8_LDA(dst, b, h) do { _Pragma("unroll") for (int m = 0; m < 4; ++m) _Pragma("unroll") for (int k = 0; k < 2; ++k) dst[m][k] = *(const LAS bf16x8*)(lds + PG8_SA(b, h) + aoff + m * 2048 + k * 1024); } while (0)
#define PG8_LDB(dst, b, h) do { _Pragma("unroll") for (int n = 0; n < 2; ++n) _Pragma("unroll") for (int k = 0; k < 2; ++k) dst[n][k] = *(const LAS bf16x8*)(lds + PG8_SB(b, h) + boff + n * 2048 + k * 1024); } while (0)
    const int f8scale = 0x7f7f7f7f;
#define PG8_MMA(ai, bj, At, Bt) do { __builtin_amdgcn_s_setprio(1); if constexpr (FP8) { _Pragma("unroll") for (int m = 0; m < 4; ++m) _Pragma("unroll") for (int n = 0; n < 2; ++n) { \
            const i32x8 _b8 = __builtin_shufflevector((i32x4)Bt[n][0], (i32x4)Bt[n][1], 0, 1, 2, 3, 4, 5, 6, 7), _a8 = __builtin_shufflevector((i32x4)At[m][0], (i32x4)At[m][1], 0, 1, 2, 3, 4, 5, 6, 7); \
            asm volatile("v_mfma_scale_f32_16x16x128_f8f6f4 %0, %1, %2, %0, %3, %3 op_sel_hi:[0,0,0]" : "+v"(acc[ai][bj][m][n]) : "v"(_b8), "v"(_a8), "v"(f8scale)); } } else { \
        _Pragma("unroll") for (int m = 0; m < 4; ++m) _Pragma("unroll") for (int n = 0; n < 2; ++n) _Pragma("unroll") for (int k = 0; k < 2; ++k) \
        acc[ai][bj][m][n] = __builtin_amdgcn_mfma_f32_16x16x32_bf16(Bt[n][k], At[m][k], acc[ai][bj][m][n], 0, 0, 0); } __builtin_amdgcn_s_setprio(0); } while (0)
#define PG8_WAIT_V(n) asm volatile("s_waitcnt vmcnt(" #n ")" ::: "memory")
#define PG8_WAIT_L(n) asm volatile("s_waitcnt lgkmcnt(" #n ")" ::: "memory")
#define PG8_BAR __builtin_amdgcn_s_barrier()
#define PG8_SCHED __builtin_amdgcn_sched_barrier(0)
#define PG8_VOFF(dst, un) do { _Pragma("unroll") for (int _h = 0; _h < 2; ++_h) _Pragma("unroll") for (int _i = 0; _i < 2; ++_i) \
        dst[_h][_i] = GATHER ? (unsigned)S.arow(un, _h * HALF + RA[_i]) * (unsigned)(lda * ESZ) + (unsigned)(CA[_i] * 2) : (unsigned)((_h * HALF + RA[_i]) * lda * ESZ + CA[_i] * 2); } while (0)
    Unit cur, nxt, nx2; int ui = 0; bool has_next = false; int ridx[2][2];
#define PG8_RIDX(un) do { _Pragma("unroll") for (int _h = 0; _h < 2; ++_h) _Pragma("unroll") for (int _i = 0; _i < 2; ++_i) ridx[_h][_i] = S.arow(un, _h * HALF + RA[_i]); } while (0)
    if (!S.next(0, cur)) return;
    PG8_VOFF(vc, cur);
    if constexpr (GATHER) { has_next = S.next(1, nxt); if (has_next) PG8_RIDX(nxt); }
    f32x4 acc[2][2][4][2];
#pragma unroll
    for (int a = 0; a < 2; ++a)
#pragma unroll
        for (int b = 0; b < 2; ++b)
#pragma unroll
            for (int m = 0; m < 4; ++m)
#pragma unroll
                for (int n = 0; n < 2; ++n) acc[a][b][m][n] = (f32x4){0.f, 0.f, 0.f, 0.f};
    bf16x8 At[4][2], B0[2][2], B1[2][2];
    const char* cA = uniform_ptr(cur.A); const char* cB = uniform_ptr(cur.B);
    if (GATHER) PG8_WAIT_V(0);
    PG8_STAGE_B(PG8_SB(0, 0), cB); PG8_STAGE_B(PG8_SB(0, 1), cB + hstepB); PG8_STAGE_A(PG8_SA(0, 0), cA, vc, 0); PG8_STAGE_A(PG8_SA(0, 1), cA, vc, 1);
    if (wr == 1) PG8_BAR;
    PG8_WAIT_V(2); PG8_BAR;
    PG8_STAGE_B(PG8_SB(1, 0), cB + kstep); PG8_STAGE_A(PG8_SA(1, 0), cA + kstep, vc, 0); PG8_STAGE_B(PG8_SB(1, 1), cB + hstepB + kstep);
    PG8_WAIT_V(6); PG8_BAR;
    for (;;) {
        if constexpr (!GATHER) has_next = S.next(ui + 1, nxt);
        const char* nA = has_next ? uniform_ptr(nxt.A) : cA; const char* nB = has_next ? uniform_ptr(nxt.B) : cB;
        bool has_nx2 = false;
        if constexpr (GATHER) {
#pragma unroll
            for (int h = 0; h < 2; ++h)
#pragma unroll
                for (int i = 0; i < 2; ++i) vn[h][i] = has_next ? (unsigned)ridx[h][i] * (unsigned)(lda * ESZ) + (unsigned)(CA[i] * 2) : vc[h][i];
            has_nx2 = has_next && S.next(ui + 2, nx2); if (has_nx2) PG8_RIDX(nx2); }
        for (int t = 0; t < nt; t += 2) {
            const bool last = (t == nt - 2);
            const char* a1 = cA + (size_t)(t + 1) * kstep;
            const char* a2 = last ? nA : cA + (size_t)(t + 2) * kstep; const char* b2 = last ? nB : cB + (size_t)(t + 2) * kstep;
            const char* a3 = a2 + kstep; const char* b3 = b2 + kstep;
            unsigned v2[2][2];
#pragma unroll
            for (int h = 0; h < 2; ++h) { v2[h][0] = (GATHER && last) ? vn[h][0] : vc[h][0]; v2[h][1] = (GATHER && last) ? vn[h][1] : vc[h][1]; }
            PG8_LDB(B0, 0, 0); PG8_LDB(B1, 0, 1); PG8_SCHED; PG8_LDA(At, 0, 0); PG8_STAGE_A(PG8_SA(1, 1), a1, vc, 1);
            PG8_WAIT_V(8); PG8_WAIT_L(0); PG8_BAR; PG8_MMA(0, 0, At, B0); PG8_MMA(0, 1, At, B1); PG8_BAR; PG8_SCHED;
            PG8_LDA(At, 0, 1); PG8_STAGE_B(PG8_SB(0, 0), b2); PG8_STAGE_B(PG8_SB(0, 1), b2 + hstepB); PG8_STAGE_A(PG8_SA(0, 0), a2, v2, 0);
            PG8_WAIT_V(8); PG8_WAIT_L(0); PG8_BAR; PG8_MMA(1, 0, At, B0); PG8_MMA(1, 1, At, B1); PG8_BAR; PG8_SCHED;
            PG8_LDB(B0, 1, 0); PG8_LDB(B1, 1, 1); PG8_SCHED; PG8_LDA(At, 1, 0); PG8_STAGE_A(PG8_SA(0, 1), a2, v2, 1);
            PG8_WAIT_V(8); PG8_WAIT_L(0); PG8_BAR; PG8_MMA(0, 0, At, B0); PG8_MMA(0, 1, At, B1); PG8_BAR; PG8_SCHED;
            PG8_LDA(At, 1, 1); PG8_STAGE_B(PG8_SB(1, 0), b3); PG8_STAGE_B(PG8_SB(1, 1), b3 + hstepB); PG8_STAGE_A(PG8_SA(1, 0), a3, v2, 0);
            PG8_WAIT_V(8); PG8_WAIT_L(0); PG8_BAR; PG8_MMA(1, 0, At, B0); PG8_MMA(1, 1, At, B1); PG8_BAR; PG8_SCHED;
        }
        if constexpr (ALIGN_EPI) { if (wr == 0) PG8_BAR; }
        if constexpr (FP8) asm volatile("s_nop 15\n\ts_nop 15" ::: "memory");
        { int frx = fr, fqx = fq; asm volatile("" : "+v"(frx), "+v"(fqx));
          run_epilogue<Epi, PAIR>(E, acc, cur, wr, wc, frx, fqx); }
        if (!has_next) break;
#pragma unroll
        for (int a = 0; a < 2; ++a)
#pragma unroll
            for (int b = 0; b < 2; ++b)
#pragma unroll
                for (int m = 0; m < 4; ++m)
#pragma unroll
                    for (int n = 0; n < 2; ++n) acc[a][b][m][n] = (f32x4){0.f, 0.f, 0.f, 0.f};
        cur = nxt; cA = nA; cB = nB; ++ui;
        if constexpr (GATHER) { nxt = nx2; has_next = has_nx2;
#pragma unroll
            for (int h = 0; h < 2; ++h) { vc[h][0] = vn[h][0]; vc[h][1] = vn[h][1]; } }
        if constexpr (ALIGN_EPI) { if (wr == 1) PG8_BAR; }
    }
    PG8_WAIT_V(0);
    if constexpr (!ALIGN_EPI) { if (wr == 0) PG8_BAR; }
    PG8_BAR;
#undef PG8_SA
#undef PG8_SB
#undef PG8_STAGE_A
#undef PG8_STAGE_B
#undef PG8_GLDS
#undef PG8_LDA
#undef PG8_LDB
#undef PG8_MMA
#undef PG8_WAIT_V
#undef PG8_WAIT_L
#undef PG8_BAR
#undef PG8_SCHED
#undef PG8_VOFF
#undef PG8_RIDX
}
}

#define XB_TMO      128
#define XB_XCNT(j)  (256  + 64 * (j))
#define XB_XSUB(j)  (1280 + 64 * (j))
#define XB_XGEN(j)  (2304 + 64 * (j))
#define XB_TOP      3328
#define XB_TOPGEN   3392
#define XCD_BAR_WORDS 3456
#define XB_SPIN_CAP (1u << 18)
__device__ __forceinline__ unsigned xb_ld(unsigned* p)              { return __hip_atomic_load(p, __ATOMIC_RELAXED, __HIP_MEMORY_SCOPE_AGENT); }
__device__ __forceinline__ unsigned xb_add(unsigned* p, unsigned v) { return __hip_atomic_fetch_add(p, v, __ATOMIC_RELAXED, __HIP_MEMORY_SCOPE_AGENT); }
__device__ __forceinline__ unsigned xb_xcc_id() { return (unsigned)__builtin_amdgcn_s_getreg((3 << 11) | 20) & 0xFu; }
#define XB_SPIN(cond, bar) do { unsigned _sp = 0; while (cond) { __builtin_amdgcn_s_sleep(1); \
    if ((++_sp & 255u) == 0u) { if (xb_ld(&(bar)[XB_TMO])) break; if (_sp > XB_SPIN_CAP) { atomicAdd(&(bar)[XB_TMO], 1u); break; } } } } while (0)
struct XcdBarrier { unsigned* bar; unsigned x; volatile LAS unsigned* st; };
__device__ __forceinline__ XcdBarrier xcd_barrier_post(unsigned* bar, volatile LAS unsigned* st) {
    XcdBarrier b; b.bar = bar; b.x = xb_xcc_id(); b.st = st;
    if (threadIdx.x == 0) (void)xb_add(&bar[XB_XCNT(b.x)], 1u);
    return b;
}
__device__ __forceinline__ void xcd_barrier_complete(unsigned* bar, unsigned x, unsigned& nloc, unsigned& nx) {
    const unsigned G = gridDim.x * gridDim.y * gridDim.z;
    unsigned sum, cnt, mine, sp = 0u;
    for (;;) {
        sum = 0u; cnt = 0u; mine = 0u;
#pragma unroll
        for (unsigned j = 0; j < 16; ++j) { const unsigned c = xb_ld(&bar[XB_XCNT(j)]); sum += c; cnt += (c > 0u) ? 1u : 0u; mine = (j == x) ? c : mine; }
        if (sum == G) break;
        __builtin_amdgcn_s_sleep(1);
        if ((++sp & 255u) == 0u) { if (xb_ld(&bar[XB_TMO])) break; if (sp > XB_SPIN_CAP) { atomicAdd(&bar[XB_TMO], 1u); break; } }
    }
    nloc = mine > 0u ? mine : 1u; nx = cnt > 0u ? cnt : 1u;
}
__device__ __forceinline__ void xcd_barrier(const XcdBarrier& b) {
    asm volatile("s_waitcnt vmcnt(0)" ::: "memory");
    __syncthreads();
    if (threadIdx.x == 0) {
        unsigned* bar = b.bar;
        __builtin_amdgcn_s_waitcnt(0);
        unsigned nloc = b.st[0], nx = b.st[1];
        if (nloc == 0u) { xcd_barrier_complete(bar, b.x, nloc, nx); b.st[0] = nloc; b.st[1] = nx; }
        const unsigned old = xb_add(&bar[XB_XSUB(b.x)], 1u);
        const unsigned gen = old / nloc;
        if (old + 1u == (gen + 1u) * nloc) {
            __builtin_amdgcn_fence(__ATOMIC_RELEASE, "agent");
            asm volatile("s_waitcnt vmcnt(0)" ::: "memory");
            const unsigned og = xb_add(&bar[XB_TOP], 1u);
            const unsigned tg = og / nx;
            if (og + 1u == (tg + 1u) * nx) xb_add(&bar[XB_TOPGEN], 1u);
            else XB_SPIN(xb_ld(&bar[XB_TOPGEN]) == tg, bar);
            __builtin_amdgcn_fence(__ATOMIC_ACQUIRE, "agent");
            xb_add(&bar[XB_XGEN(b.x)], 1u);
            asm volatile("s_waitcnt vmcnt(0)" ::: "memory");
        } else {
            XB_SPIN(xb_ld(&bar[XB_XGEN(b.x)]) == gen, bar);
            __builtin_amdgcn_fence(__ATOMIC_ACQUIRE, "agent");
            asm volatile("s_waitcnt vmcnt(0)" ::: "memory");
        }
    }
    __syncthreads();
}

constexpr int NWAVES = 8, NTHREADS = 512;
constexpr int LDS_BYTES = 147456;
constexpr int LDS_MISC = 147456 - 256;
struct Args { const float* in[N_IN]; float* out; unsigned char* ws; int ph_lo, ph_hi; };
struct Frame { LAS unsigned char* lds; int tid, lane, wave, gw, NGW; const Args* a; unsigned char* ws; float* X; bf16* XN; bf16* wsm; bf16* wmoe; unsigned* ctl; };

struct CvtCtx { int gw, NGW, lane, base; LAS float* scr; };
__device__ __forceinline__ void cvt_mat(CvtCtx& c, const float* W, int ldw, int K, int N, bf16* WT, int ldt, int drow0, int dcol0, const float* mu, int mumode, int pair, float f8scale = 0.f) {
    const int nnb = N / 64, nitems = (K / 64) * nnb, lane = c.lane;
    int start = c.gw - (c.base % c.NGW); if (start < 0) start += c.NGW;
    for (int it = start; it < nitems; it += c.NGW) {
        const int kb = it / nnb, nb = it - kb * nnb, k0 = kb * 64, n0 = nb * 64;
        const int drow = drow0 + (pair ? ((n0 >> 7) << 8) + (n0 & 127) + (pair == 2 ? 128 : 0) : n0);
        f32x4 v[16];
#pragma unroll
        for (int i = 0; i < 16; ++i) v[i] = __builtin_nontemporal_load((const f32x4*)(W + (size_t)(k0 + 4 * i + (lane >> 4)) * ldw + n0 + (lane & 15) * 4));
#pragma unroll
        for (int i = 0; i < 16; ++i) {
            const int kk = 4 * i + (lane >> 4);
            if (mumode) { const float m = mu[k0 + kk]; const float sc = mumode == 1 ? 1.f - m : m; v[i] = v[i] * sc; }
            LAS float* p = c.scr + kk * 65 + (lane & 15) * 4; p[0] = v[i].x; p[1] = v[i].y; p[2] = v[i].z; p[3] = v[i].w;
        }
        LDS_WAIT();
        if (f8scale != 0.f) {
#pragma unroll
            for (int i = 0; i < 4; ++i) {
                const int n = 16 * i + (lane >> 2), cch = lane & 3; const LAS float* sp = c.scr + (16 * cch) * 65 + n;
                u32x4 o; o.x = pk4_fp8(sp[0] * f8scale, sp[65] * f8scale, sp[130] * f8scale, sp[195] * f8scale); o.y = pk4_fp8(sp[260] * f8scale, sp[325] * f8scale, sp[390] * f8scale, sp[455] * f8scale);
                o.z = pk4_fp8(sp[520] * f8scale, sp[585] * f8scale, sp[650] * f8scale, sp[715] * f8scale); o.w = pk4_fp8(sp[780] * f8scale, sp[845] * f8scale, sp[910] * f8scale, sp[975] * f8scale);
                *(u32x4*)((unsigned char*)WT + (size_t)(drow + n) * ldt + dcol0 + k0 + 16 * cch) = o;
            }
        } else {
#pragma unroll 4
        for (int i = 0; i < 8; ++i) {
            const int n = 8 * i + (lane >> 3), cch = lane & 7; const LAS float* s = c.scr + (8 * cch) * 65 + n;
            u32x4 o; o.x = pk2(s[0], s[65]); o.y = pk2(s[130], s[195]); o.z = pk2(s[260], s[325]); o.w = pk2(s[390], s[455]);
            *(u32x4*)(WT + (size_t)(drow + n) * ldt + dcol0 + k0 + 8 * cch) = o;
        }
        }
        LDS_WAIT();
    }
    c.base += nitems;
}
__device__ __forceinline__ void cvt_moe(Frame& F, CvtCtx& c, int layer, bool fp8) {
    const float* wg = F.a->in[I_M_W_GATE] + (size_t)layer * NE * D * FF; const float* wu = F.a->in[I_M_W_UP] + (size_t)layer * NE * D * FF;
    const float* wd = F.a->in[I_M_W_DOWN] + (size_t)layer * NE * D * FF;
    const float sc = fp8 ? 32.0f : 0.f; const int esz = fp8 ? 1 : 2;
    for (int e = 0; e < NE; ++e) {
        bf16* gu = (bf16*)((unsigned char*)F.wmoe + (size_t)e * MWGU_STRIDE * esz); bf16* dn = (bf16*)((unsigned char*)F.wmoe + (MWD_OFF + (size_t)e * MWD_STRIDE) * esz);
        cvt_mat(c, wg + (size_t)e * D * FF, FF, D, FF, gu, D, 0, 0, nullptr, 0, 1, sc);
        cvt_mat(c, wu + (size_t)e * D * FF, FF, D, FF, gu, D, 0, 0, nullptr, 0, 2, sc);
        cvt_mat(c, wd + (size_t)e * D * FF, D, FF, D, dn, FF, 0, 0, nullptr, 0, 0, sc);
    }
}

__device__ __forceinline__ void load_row(const float* xr, int lane, f32x4 (&v)[4]) {
#pragma unroll
    for (int j = 0; j < 4; ++j) v[j] = ((const f32x4*)xr)[lane + 64 * j];
}
__device__ __forceinline__ float row_rinv(const f32x4 (&v)[4]) {
    float s = 0.f;
#pragma unroll
    for (int j = 0; j < 4; ++j) s += (v[j].x * v[j].x + v[j].y * v[j].y) + (v[j].z * v[j].z + v[j].w * v[j].w);
    return rsqrtf(wave_sum(s) * (1.0f / D) + 1e-6f);
}
__device__ __forceinline__ void store_row_bf16(bf16* orow, int lane, const f32x4 (&v)[4]) {
#pragma unroll
    for (int j = 0; j < 4; ++j) { u32x2 w; w.x = pk2(v[j].x, v[j].y); w.y = pk2(v[j].z, v[j].w); ((u32x2*)orow)[lane + 64 * j] = w; }
}

__device__ __forceinline__ void ph_prologue(Frame& F) {
    const Args& a = *F.a;
    CvtCtx c; c.gw = F.gw; c.NGW = F.NGW; c.lane = F.lane; c.base = 0; c.scr = (LAS float*)(F.lds + F.wave * 16640);
    bf16* w = F.wsm;
    cvt_moe(F, c, 0, true);
    for (int l = 0; l < 2; ++l) {
        cvt_mat(c, a.in[I_A_W_IN] + (size_t)l * D * 2 * D, 2 * D, D, 2 * D, w + WA_IN + (size_t)l * 2 * D * D, D, 0, 0, nullptr, 0, 0);
        cvt_mat(c, a.in[I_A_W_OUT] + (size_t)l * D * D, D, D, D, w + WA_OUT + (size_t)l * D * D, D, 0, 0, nullptr, 0, 0);
        cvt_mat(c, a.in[I_F_W_GATE] + (size_t)l * D * FF, FF, D, FF, w + WF_GU + (size_t)l * 2 * FF * D, D, 0, 0, nullptr, 0, 1);
        cvt_mat(c, a.in[I_F_W_UP] + (size_t)l * D * FF, FF, D, FF, w + WF_GU + (size_t)l * 2 * FF * D, D, 0, 0, nullptr, 0, 2);
        cvt_mat(c, a.in[I_F_W_DOWN] + (size_t)l * D * FF, D, FF, D, w + WF_D + (size_t)l * D * FF, FF, 0, 0, nullptr, 0, 0);
    }
    cvt_mat(c, a.in[I_B_W_IN], D, D, D, w + WB_IN, D, 0, 0, nullptr, 0, 0);
    cvt_mat(c, a.in[I_B_W_OUT], D, D, D, w + WB_OUT, D, 0, 0, nullptr, 0, 0);
    for (int g = 0; g < 4; ++g) cvt_mat(c, a.in[I_B_W_GRP] + (size_t)g * 65536, 256, 256, 256, w + WB_GRP + (size_t)g * 65536, 256, 0, 0, nullptr, 0, 0);
    const float* mu = a.in[I_C_MU];
    for (int n = 0; n < 3; ++n) cvt_mat(c, a.in[I_C_W_RKV] + (size_t)n * D * D, D, D, D, w + WC1, D, n * D, 0, nullptr, 0, 0);
    cvt_mat(c, a.in[I_C_W1], 64, D, 64, w + WC1L, 2 * D, 0, 0, mu + 3 * D, 1, 0);
    cvt_mat(c, a.in[I_C_W1], 64, D, 64, w + WC1L, 2 * D, 0, D, mu + 3 * D, 2, 0);
    cvt_mat(c, a.in[I_C_A1], 64, D, 64, w + WC1L, 2 * D, 64, 0, mu + 4 * D, 1, 0);
    cvt_mat(c, a.in[I_C_A1], 64, D, 64, w + WC1L, 2 * D, 64, D, mu + 4 * D, 2, 0);
    cvt_mat(c, a.in[I_C_G1], 128, D, 128, w + WC1L, 2 * D, 128, 0, mu + 5 * D, 1, 0);
    cvt_mat(c, a.in[I_C_G1], 128, D, 128, w + WC1L, 2 * D, 128, D, mu + 5 * D, 2, 0);
    cvt_mat(c, a.in[I_C_W2], D, 64, D, w + WC2, 256, 0, 0, nullptr, 0, 0);
    cvt_mat(c, a.in[I_C_A2], D, 64, D, w + WC2, 256, D, 64, nullptr, 0, 0);
    cvt_mat(c, a.in[I_C_G2], D, 128, D, w + WC2, 256, 2 * D, 128, nullptr, 0, 0);
    cvt_mat(c, a.in[I_C_W_O], D, D, D, w + WC_O, D, 0, 0, nullptr, 0, 0);
    const int gt = F.gw * 64 + F.lane, NGT = F.NGW * 64;
    for (int i = gt; i < 3072 * 32; i += NGT) { const int r = i >> 5, q = i & 31, blk = r >> 10;
        const bool in = blk == 0 ? (q < 8) : (blk == 1 ? (q >= 8 && q < 16) : (q >= 16));
        if (!in) *(u32x4*)(w + WC2 + (size_t)r * 256 + q * 8) = (u32x4){0u, 0u, 0u, 0u}; }
    for (int i = gt; i < 2 * 8 * 128 * 128; i += NGT) { const int s = i & 127, t = (i >> 7) & 127; w[WA_S + i] = (bf16)(s <= t ? f2bf(a.in[I_A_W_S][i]) : 0u); }
    for (int m = F.gw; m < T; m += F.NGW) {
        f32x4 v[4]; load_row(a.in[I_X] + (size_t)m * D, F.lane, v);
        const float rinv = row_rinv(v);
#pragma unroll
        for (int j = 0; j < 4; ++j) v[j] = v[j] * rinv * ((const f32x4*)a.in[I_NORM_MIX])[F.lane + 64 * j];
        store_row_bf16(F.XN + (size_t)m * D, F.lane, v);
    }
}
__device__ __forceinline__ void ph_norm(Frame& F, const float* gain) {
    for (int m = F.gw; m < T; m += F.NGW) {
        f32x4 v[4]; load_row(F.X + (size_t)m * D, F.lane, v);
        const float rinv = row_rinv(v);
#pragma unroll
        for (int j = 0; j < 4; ++j) v[j] = v[j] * rinv * ((const f32x4*)gain)[F.lane + 64 * j];
        store_row_bf16(F.XN + (size_t)m * D, F.lane, v);
    }
}
__device__ __forceinline__ void ph_spatial(Frame& F, int l) {
    typedef short bf16x8 __attribute__((ext_vector_type(8)));
    const Args& a = *F.a;
    const bf16* U = (const bf16*)(F.ws + WS_BIG + B_U); const bf16* V = (const bf16*)(F.ws + WS_BIG + B_V); bf16* G = (bf16*)(F.ws + WS_BIG + B_GATED);
    const f32x2* vpart = (const f32x2*)(F.ws + WS_BIG + B_VPART);
    const float* lng = a.in[I_A_LN_G] + l * D; const float* lnb = a.in[I_A_LN_B] + l * D; const float* bs = a.in[I_A_B_S] + l * 8 * 128;
    const bf16* ws = F.wsm + WA_S + (size_t)l * 8 * 128 * 128;
    constexpr int RS = 272;
    LAS unsigned char* Wb = F.lds; LAS unsigned char* Vt = F.lds + 128 * RS; LAS float* stat = (LAS float*)(F.lds + 2 * 128 * RS);
    const int tid = F.tid, lane = F.lane, w = F.wave, fr = lane & 15, fq = lane >> 4;
    for (int u = blockIdx.x; u < 1024; u += gridDim.x) {
        const int g = u & 7, bc = u >> 3, t0 = bc * 128;
        __syncthreads();
        if (tid < 128) { float ps = 0.f, pq = 0.f; const f32x4* pp = (const f32x4*)(vpart + (size_t)(t0 + tid) * 32);
#pragma unroll
            for (int q = 0; q < 16; ++q) { const f32x4 x = pp[q]; ps += x.x + x.z; pq += x.y + x.w; }
            const float mean = ps * (1.0f / D), var = pq * (1.0f / D) - mean * mean; stat[tid * 2] = mean; stat[tid * 2 + 1] = rsqrtf(fmaxf(var, 0.f) + 1e-5f); }
        { const int t = tid >> 2, sc = (tid & 3) * 32;
#pragma unroll
          for (int q = 0; q < 4; ++q) *(LAS u32x4*)(Wb + t * RS + (sc + 8 * q) * 2) = *(const u32x4*)(ws + (size_t)g * 16384 + t * 128 + sc + 8 * q); }
        __syncthreads();
        { const int sidx = tid & 127, dq = tid >> 7; const float mean = stat[sidx * 2], rstd = stat[sidx * 2 + 1]; const size_t ro = (size_t)(t0 + sidx) * D + g * 128 + dq * 32;
          u32x4 wv[4];
#pragma unroll
          for (int q = 0; q < 4; ++q) wv[q] = *(const u32x4*)(V + ro + q * 8);
#pragma unroll
          for (int q = 0; q < 4; ++q) { const int c = g * 128 + dq * 32 + q * 8;
              const float x[8] = {bflo(wv[q].x), bfhi(wv[q].x), bflo(wv[q].y), bfhi(wv[q].y), bflo(wv[q].z), bfhi(wv[q].z), bflo(wv[q].w), bfhi(wv[q].w)};
#pragma unroll
              for (int i = 0; i < 8; ++i) *(LAS bf16*)(Vt + (dq * 32 + q * 8 + i) * RS + sidx * 2) = (bf16)f2bf((x[i] - mean) * rstd * lng[c + i] + lnb[c + i]); } }
        __syncthreads();
        const int dh = w >> 2;
#pragma unroll
        for (int half = 0; half < 2; ++half) {
            const int ti = half ? 7 - (w & 3) : (w & 3), nks = (ti >> 1) + 1;
            f32x4 acc[4];
#pragma unroll
            for (int j = 0; j < 4; ++j) acc[j] = (f32x4){0.f, 0.f, 0.f, 0.f};
            for (int ks = 0; ks < nks; ++ks) {
                const bf16x8 af = *(const LAS bf16x8*)(Wb + (16 * ti + fr) * RS + (32 * ks + 8 * fq) * 2);
#pragma unroll
                for (int j = 0; j < 4; ++j) { const bf16x8 bfv = *(const LAS bf16x8*)(Vt + (16 * (dh * 4 + j) + fr) * RS + (32 * ks + 8 * fq) * 2);
                    acc[j] = __builtin_amdgcn_mfma_f32_16x16x32_bf16(bfv, af, acc[j], 0, 0, 0); }
            }
            const int t = 16 * ti + fr; const float bias = bs[g * 128 + t];
#pragma unroll
            for (int j = 0; j < 4; ++j) { const size_t o = (size_t)(t0 + t) * D + g * 128 + 16 * (dh * 4 + j) + 4 * fq;
                const u32x2 uu = *(const u32x2*)(U + o); u32x2 r;
                r.x = pk2(bflo(uu.x) * (acc[j][0] + bias), bfhi(uu.x) * (acc[j][1] + bias)); r.y = pk2(bflo(uu.y) * (acc[j][2] + bias), bfhi(uu.y) * (acc[j][3] + bias));
                *(u32x2*)(G + o) = r; }
        }
    }
    __syncthreads();
}
template <int WIN> __device__ __forceinline__ void pool_row(const bf16* P, bf16* DD, int t, int c4) {
    const int pos = t & (SEQ - 1); u32x2 w[WIN];
#pragma unroll
    for (int k = 0; k < WIN; ++k) { const int tt = t - (k <= pos ? k : 0); w[k] = *(const u32x2*)(P + (size_t)tt * D + c4); }
    const f32x4 p0 = (f32x4){bflo(w[0].x), bfhi(w[0].x), bflo(w[0].y), bfhi(w[0].y)}; f32x4 s = p0;
#pragma unroll
    for (int k = 1; k < WIN; ++k) { const float m = k <= pos ? 1.0f : 0.0f; s += (f32x4){bflo(w[k].x), bfhi(w[k].x), bflo(w[k].y), bfhi(w[k].y)} * m; }
    const int cnt = (pos + 1) < WIN ? (pos + 1) : WIN;
    const f32x4 d = s * (1.0f / (float)cnt) - p0;
    u32x2 o; o.x = pk2(d.x, d.y); o.y = pk2(d.z, d.w); *(u32x2*)(DD + (size_t)t * D + c4) = o;
}
__device__ __forceinline__ void ph_pool(Frame& F) {
    const bf16* P = (const bf16*)(F.ws + WS_BIG + B_P); bf16* DD = (bf16*)(F.ws + WS_BIG + B_DD);
    for (int wi = F.gw; wi < T * 4; wi += F.NGW) {
        const int t = wi >> 2, g = wi & 3, c4 = g * 256 + F.lane * 4;
        if (g == 0) pool_row<2>(P, DD, t, c4); else if (g == 1) pool_row<4>(P, DD, t, c4); else if (g == 2) pool_row<8>(P, DD, t, c4); else pool_row<16>(P, DD, t, c4);
    }
}
__device__ __forceinline__ void ph_route(Frame& F, int layer, const float* gain, bool fp8out) {
    const Args& a = *F.a;
    const float* Rt = a.in[I_M_ROUTER] + (size_t)layer * D * NE;
    int* tokE = (int*)(F.ws + WS_ROUTE + RT_TOKE); int* tokSlot = (int*)(F.ws + WS_ROUTE + RT_TOKSLOT); float* tokGate = (float*)(F.ws + WS_ROUTE + RT_TOKGATE);
    int* slotTok = (int*)(F.ws + WS_ROUTE + RT_SLOTTOK); unsigned* cnt = F.ctl + CW_CNT + 64 * layer;
    LAS int* rowE = (LAS int*)F.lds;
    LAS int* rank = rowE + 128;
    LAS int* baseS = rank + 128;
    for (int blk = blockIdx.x; blk < T / 64; blk += gridDim.x) {
        __syncthreads();
        for (int r = F.wave; r < 64; r += NWAVES) {
            const int m = blk * 64 + r;
            f32x4 v[4]; load_row(F.X + (size_t)m * D, F.lane, v);
            const float rinv = row_rinv(v);
            float lg[8];
#pragma unroll
            for (int e = 0; e < 8; ++e) lg[e] = 0.f;
#pragma unroll
            for (int j = 0; j < 4; ++j) {
                v[j] = v[j] * rinv * ((const f32x4*)gain)[F.lane + 64 * j];
                const int d0 = 4 * F.lane + 256 * j;
#pragma unroll
                for (int i = 0; i < 4; ++i) { const f32x4 r0 = *(const f32x4*)(Rt + (size_t)(d0 + i) * 8), r1 = *(const f32x4*)(Rt + (size_t)(d0 + i) * 8 + 4); const float h = v[j][i];
                    lg[0] += h * r0.x; lg[1] += h * r0.y; lg[2] += h * r0.z; lg[3] += h * r0.w; lg[4] += h * r1.x; lg[5] += h * r1.y; lg[6] += h * r1.z; lg[7] += h * r1.w; }
            }
            if (fp8out) {
#pragma unroll
                for (int j = 0; j < 4; ++j) ((unsigned*)((unsigned char*)F.XN + (size_t)m * D))[F.lane + 64 * j] = pk4_fp8(v[j].x, v[j].y, v[j].z, v[j].w);
            } else store_row_bf16(F.XN + (size_t)m * D, F.lane, v);
#pragma unroll
            for (int e = 0; e < 8; ++e) lg[e] = wave_sum(lg[e]);
            int e0 = 0; float l0 = lg[0];
#pragma unroll
            for (int e = 1; e < 8; ++e) if (lg[e] > l0) { l0 = lg[e]; e0 = e; }
            int e1 = -1; float l1 = -3.0e38f;
#pragma unroll
            for (int e = 0; e < 8; ++e) if (e != e0 && lg[e] > l1) { l1 = lg[e]; e1 = e; }
            if (F.lane == 0) { const float g1 = 1.0f / (1.0f + __expf(l0 - l1)); rowE[r * 2] = e0; rowE[r * 2 + 1] = e1; tokGate[m * 2] = 1.0f - g1; tokGate[m * 2 + 1] = g1; tokE[m * 2] = e0; tokE[m * 2 + 1] = e1; }
        }
        __syncthreads();
        if (F.tid < 8) { int c = 0; for (int i = 0; i < 128; ++i) if (rowE[i] == F.tid) rank[i] = c++; baseS[F.tid] = c ? (int)atomicAdd(cnt + F.tid, (unsigned)c) : 0; }
        __syncthreads();
        if (F.tid < 128) { const int e = rowE[F.tid], slot = baseS[e] + rank[F.tid], m = blk * 64 + (F.tid >> 1); tokSlot[m * 2 + (F.tid & 1)] = slot; slotTok[e * CAP + slot] = m; }
    }
    __syncthreads();
}
struct CombineCtx { const int* tokE; const int* tokSlot; const float* tokGate; const bf16* YK; int pst[8]; };
__device__ __forceinline__ float combine_row(Frame& F, const CombineCtx& C, int m, f32x4 (&v)[4]) {
    const int e0 = C.tokE[m * 2], e1 = C.tokE[m * 2 + 1]; int p0 = 0, p1 = 0;
#pragma unroll
    for (int e = 0; e < 8; ++e) { p0 = e == e0 ? C.pst[e] : p0; p1 = e == e1 ? C.pst[e] : p1; }
    const size_t r0 = (size_t)(p0 + C.tokSlot[m * 2]) * D, r1 = (size_t)(p1 + C.tokSlot[m * 2 + 1]) * D; const float g0 = C.tokGate[m * 2], g1 = C.tokGate[m * 2 + 1];
    load_row(F.X + (size_t)m * D, F.lane, v);
#pragma unroll
    for (int j = 0; j < 4; ++j) { const u32x2 a = ((const u32x2*)(C.YK + r0))[F.lane + 64 * j], b = ((const u32x2*)(C.YK + r1))[F.lane + 64 * j];
        v[j].x += g0 * bflo(a.x) + g1 * bflo(b.x); v[j].y += g0 * bfhi(a.x) + g1 * bfhi(b.x); v[j].z += g0 * bflo(a.y) + g1 * bflo(b.y); v[j].w += g0 * bfhi(a.y) + g1 * bfhi(b.y); }
    return row_rinv(v);
}
__device__ __forceinline__ void ph_combine(Frame& F, int layer, const float* gain, int mode, float* Xo) {
    CombineCtx C; C.tokE = (const int*)(F.ws + WS_ROUTE + RT_TOKE); C.tokSlot = (const int*)(F.ws + WS_ROUTE + RT_TOKSLOT); C.tokGate = (const float*)(F.ws + WS_ROUTE + RT_TOKGATE);
    C.YK = (const bf16*)(F.ws + WS_BIG + B_YK);
    const unsigned* cnt = F.ctl + CW_CNT + 64 * layer; { int p = 0;
#pragma unroll
        for (int e = 0; e < 8; ++e) { C.pst[e] = p; p += ((int)cnt[e] + 255) & ~255; } }
    if (mode == 1) {
        bf16* H2 = (bf16*)(F.ws + WS_BIG + B_H2); bf16* XS = (bf16*)(F.ws + WS_BIG + B_XS); const float* mu = F.a->in[I_C_MU];
        for (int blk = F.gw; blk < T / 8; blk += F.NGW) {
            const int m0 = blk * 8; f32x4 hp[4];
            if ((m0 & (SEQ - 1)) == 0) {
#pragma unroll
                for (int j = 0; j < 4; ++j) hp[j] = (f32x4){0.f, 0.f, 0.f, 0.f};
            } else { const float rinv = combine_row(F, C, m0 - 1, hp);
#pragma unroll
                for (int j = 0; j < 4; ++j) hp[j] = hp[j] * rinv * ((const f32x4*)gain)[F.lane + 64 * j]; }
            for (int m = m0; m < m0 + 8; ++m) {
                f32x4 v[4]; const float rinv = combine_row(F, C, m, v);
#pragma unroll
                for (int j = 0; j < 4; ++j) { ((f32x4*)(Xo + (size_t)m * D))[F.lane + 64 * j] = v[j]; v[j] = v[j] * rinv * ((const f32x4*)gain)[F.lane + 64 * j]; }
                store_row_bf16(H2 + (size_t)m * 2 * D, F.lane, v); store_row_bf16(H2 + (size_t)m * 2 * D + D, F.lane, hp);
#pragma unroll
                for (int n = 0; n < 3; ++n) { f32x4 xs[4];
#pragma unroll
                    for (int j = 0; j < 4; ++j) { const f32x4 mm = ((const f32x4*)(mu + n * D))[F.lane + 64 * j]; xs[j] = v[j] + (hp[j] - v[j]) * mm; }
                    store_row_bf16(XS + (size_t)n * ((size_t)T * D) + (size_t)m * D, F.lane, xs); }
#pragma unroll
                for (int j = 0; j < 4; ++j) hp[j] = v[j];
            }
        }
        return;
    }
    for (int m = F.gw; m < T; m += F.NGW) {
        f32x4 v[4]; const float rinv = combine_row(F, C, m, v);
        if (mode == 0) {
#pragma unroll
            for (int j = 0; j < 4; ++j) ((f32x4*)(Xo + (size_t)m * D))[F.lane + 64 * j] = v[j];
        }
#pragma unroll
        for (int j = 0; j < 4; ++j) v[j] = v[j] * rinv * ((const f32x4*)gain)[F.lane + 64 * j];
        if (mode == 0) store_row_bf16(F.XN + (size_t)m * D, F.lane, v);
        else {
#pragma unroll
            for (int j = 0; j < 4; ++j) ((f32x4*)(Xo + (size_t)m * D))[F.lane + 64 * j] = v[j];
        }
    }
}
template <int CTRL> __device__ __forceinline__ float dppf(float v) { return __uint_as_float((unsigned)__builtin_amdgcn_update_dpp(0, (int)__float_as_uint(v), CTRL, 0xF, 0xF, true)); }
__device__ __forceinline__ float reduce16(float p) {
    p += dppf<0xB1>(p); p += dppf<0x4E>(p); p += dppf<0x141>(p); p += dppf<0x140>(p); return p;
}
__device__ __forceinline__ float vfma(float a, float b, float c) { float d = __builtin_fmaf(a, b, c); asm("" : "+v"(d)); return d; }
__device__ __forceinline__ float vmul(float a, float b) { float d = a * b; asm("" : "+v"(d)); return d; }
__device__ __forceinline__ f32x2 pkfma(f32x2 a, f32x2 b, f32x2 c) { f32x2 d = __builtin_elementwise_fma(a, b, c); asm("" : "+v"(d)); return d; }
__device__ __forceinline__ f32x2 pkmul(f32x2 a, f32x2 b) { f32x2 d = a * b; asm("" : "+v"(d)); return d; }
__device__ __forceinline__ float reduce8(float p) { p += dppf<0xB1>(p); p += dppf<0x4E>(p); p += dppf<0x141>(p); return p; }
__device__ __forceinline__ void ph_scan(Frame& F) {
    const Args& a = *F.a;
    const float* Rg = (const float*)(F.ws + WS_BIG + B_R); const float* Kg = (const float*)(F.ws + WS_BIG + B_K); const float* Vg = (const float*)(F.ws + WS_BIG + B_VV);
    const float* DEC = (const float*)(F.ws + WS_BIG + B_DEC); const float* AA = (const float*)(F.ws + WS_BIG + B_AA); float* Y = (float*)(F.ws + WS_BIG + B_Y);
    constexpr int VEC_F = 32 * 320, BUF_F = VEC_F + 1024, NCH = SEQ / 32;
    LAS float* sbase = (LAS float*)F.lds; LAS float* sY = sbase + 2 * BUF_F;
    const int lane = F.lane, w = F.wave;
    for (int u = blockIdx.x; u < 256; u += gridDim.x) {
        const int b = u >> 5, h = (u >> 1) & 15, half = u & 1, tb = b * SEQ;
        __syncthreads();
        if (w >= 4) {
            const int pwv = w - 4, col = h * 64 + lane, t2 = F.tid - 256;
            const float kkw = a.in[I_C_K_K][col], kaw = a.in[I_C_K_A][col];
            float pr[8], pw[8], pk[8], pa[8], pv[8];
            const __amdgpu_buffer_rsrc_t rs = __builtin_amdgcn_make_buffer_rsrc((void*)(F.ws + WS_BIG), 0, (int)(520 * MiB), 0x00020000);
            const int rbase = __builtin_amdgcn_readfirstlane(tb + pwv), cbase = __builtin_amdgcn_readfirstlane(h * 64);
            const int lo_flush = ((t2 >> 5) * D + (t2 & 31)) * 4, lane4 = lane * 4;
#define BLD(off) __uint_as_float(__builtin_amdgcn_raw_buffer_load_b32(rs, lane4, (off), 0))
#define BLH(off) __uint_as_float(((unsigned)__builtin_amdgcn_raw_buffer_load_b16(rs, lane4 >> 1, (off), 0)) << 16)
#define SCAN_LOAD(cc) do { int cco = (cc); asm volatile("" : "+s"(cco)); _Pragma("unroll") for (int q = 0; q < 8; ++q) { \
                const int ro = ((rbase + cco * 32 + 4 * q) * D + cbase) * 2; \
                pr[q] = BLH((int)B_R + ro); pw[q] = BLD((int)B_DEC + 2 * ro); pk[q] = BLH((int)B_K + ro); pa[q] = BLH((int)B_AA + ro); pv[q] = BLH((int)B_VV + ro); } } while (0)
#define SCAN_PREP(cc) do { LAS float* sbp = sbase + ((cc) & 1) * BUF_F + (lane >> 3) * 40 + (lane & 7); LAS float* svp = sbase + ((cc) & 1) * BUF_F + VEC_F + (lane & 31); _Pragma("unroll") for (int q = 0; q < 8; ++q) { \
                const int st = pwv + 4 * q; const float kk = pk[q] * kkw; float n2 = kk * kk; \
                n2 = reduce16(n2); n2 += __shfl_xor(n2, 16); n2 += __shfl_xor(n2, 32); \
                const float kkn = kk * __builtin_amdgcn_rsqf(fmaxf(n2, 1e-24f));   \
                LAS float* d = sbp + st * 320; \
                d[0] = -kkn; d[8] = pw[q]; d[16] = kkn * pa[q]; d[24] = pk[q] * (1.0f + (pa[q] - 1.0f) * kaw); d[32] = pr[q]; \
                if ((lane >> 5) == half) svp[st * 32] = pv[q]; } } while (0)
#define SCAN_FLUSH(cc) do { int cco = (cc); asm volatile("" : "+s"(cco)); const int yo = (int)B_Y + ((tb + cco * 32) * D + cbase + half * 32) * 2; _Pragma("unroll") for (int it = 0; it < 4; ++it) \
                __builtin_amdgcn_raw_buffer_store_b16((unsigned short)f2bf(sY[((cc) & 1) * 1024 + ((t2 >> 5) + 8 * it) * 32 + (t2 & 31)]), rs, lo_flush >> 1, yo + 8 * it * D * 2, 0); } while (0)
            SCAN_LOAD(0); SCAN_PREP(0); SCAN_LOAD(1);
            __syncthreads();
            for (int c = 0; c < NCH; ++c) {
                if (c + 1 < NCH) { SCAN_PREP(c + 1); if (c + 2 < NCH) SCAN_LOAD(c + 2); }
                if (c > 0) SCAN_FLUSH(c - 1);
                __syncthreads();
            }
            SCAN_FLUSH(NCH - 1);
#undef SCAN_LOAD
#undef SCAN_PREP
#undef SCAN_FLUSH
#undef BLD
#undef BLH
        } else {
            const int q8 = lane & 7, row = w * 8 + (lane >> 3);
            f32x2 S2[4];
#pragma unroll
            for (int i = 0; i < 4; ++i) S2[i] = (f32x2){0.f, 0.f};
            __syncthreads();
            for (int c = 0; c < NCH; ++c) {
                const LAS float* vp = sbase + (c & 1) * BUF_F + q8 * 40; const LAS float* sV = sbase + (c & 1) * BUF_F + VEC_F + row;
                f32x4 ca[2], cw[2], cb[2], ck[2], cr[2]; float vi = sV[0];
#pragma unroll
                for (int j = 0; j < 2; ++j) { ca[j] = *(const LAS f32x4*)(vp + 4 * j); cw[j] = *(const LAS f32x4*)(vp + 8 + 4 * j); cb[j] = *(const LAS f32x4*)(vp + 16 + 4 * j);
                    ck[j] = *(const LAS f32x4*)(vp + 24 + 4 * j); cr[j] = *(const LAS f32x4*)(vp + 32 + 4 * j); }
#pragma unroll 1
                for (int g8 = 0; g8 < 4; ++g8) {
                    float yacc = 0.f;
#pragma unroll
                    for (int s8 = 0; s8 < 8; ++s8) {
                        const int st = g8 * 8 + s8, sn = st < 31 ? st + 1 : 31;
                        f32x4 na[2], nw[2], nb[2], nk[2], nr[2];
#pragma unroll
                        for (int j = 0; j < 2; ++j) { na[j] = *(const LAS f32x4*)(vp + sn * 320 + 4 * j); nw[j] = *(const LAS f32x4*)(vp + sn * 320 + 8 + 4 * j); nb[j] = *(const LAS f32x4*)(vp + sn * 320 + 16 + 4 * j);
                            nk[j] = *(const LAS f32x4*)(vp + sn * 320 + 24 + 4 * j); nr[j] = *(const LAS f32x4*)(vp + sn * 320 + 32 + 4 * j); }
                        const float nv = sV[sn * 32];
                        __builtin_amdgcn_sched_barrier(0);
                        const f32x2 a01 = ca[0].xy, a23 = ca[0].zw, a45 = ca[1].xy, a67 = ca[1].zw, w01 = cw[0].xy, w23 = cw[0].zw, w45 = cw[1].xy, w67 = cw[1].zw;
                        const f32x2 b01 = cb[0].xy, b23 = cb[0].zw, b45 = cb[1].xy, b67 = cb[1].zw, k01 = ck[0].xy, k23 = ck[0].zw, k45 = ck[1].xy, k67 = ck[1].zw;
                        const f32x2 r01 = cr[0].xy, r23 = cr[0].zw, r45 = cr[1].xy, r67 = cr[1].zw;
                        f32x2 pp = pkmul(S2[0], a01), pq = pkmul(S2[2], a45); pp = pkfma(S2[1], a23, pp); pq = pkfma(S2[3], a67, pq);
                        const f32x2 vi2 = (f32x2){vi, vi};
                        f32x2 u0 = pkfma(S2[0], w01, pkmul(vi2, k01)), u1 = pkfma(S2[1], w23, pkmul(vi2, k23)), u2 = pkfma(S2[2], w45, pkmul(vi2, k45)), u3 = pkfma(S2[3], w67, pkmul(vi2, k67));
                        const f32x2 ps = pp + pq;
                        const float sa = reduce8(ps.x + ps.y);
                        const f32x2 sa2 = (f32x2){sa, sa};
                        S2[0] = pkfma(sa2, b01, u0); S2[1] = pkfma(sa2, b23, u1); S2[2] = pkfma(sa2, b45, u2); S2[3] = pkfma(sa2, b67, u3);
                        f32x2 yp = pkmul(S2[0], r01), yq = pkmul(S2[2], r45); yp = pkfma(S2[1], r23, yp); yq = pkfma(S2[3], r67, yq);
                        const f32x2 ys = yp + yq;
                        const float yv = reduce8(ys.x + ys.y);
                        yacc = (q8 == s8) ? yv : yacc;
#pragma unroll
                        for (int j = 0; j < 2; ++j) { ca[j] = na[j]; cw[j] = nw[j]; cb[j] = nb[j]; ck[j] = nk[j]; cr[j] = nr[j]; }
                        vi = nv;
                    }
                    sY[(c & 1) * 1024 + (g8 * 8 + q8) * 32 + row] = yacc;
                }
                __syncthreads();
            }
        }
    }
    __syncthreads();
}
__device__ __forceinline__ void ph_gnout(Frame& F) {
    const Args& a = *F.a;
    const bf16* Rg = (const bf16*)(F.ws + WS_BIG + B_R); const bf16* Kg = (const bf16*)(F.ws + WS_BIG + B_K); const bf16* Vg = (const bf16*)(F.ws + WS_BIG + B_VV);
    const bf16* AA = (const bf16*)(F.ws + WS_BIG + B_AA); const bf16* Y = (const bf16*)(F.ws + WS_BIG + B_Y); const bf16* GG = (const bf16*)(F.ws + WS_BIG + B_GG); bf16* O = (bf16*)(F.ws + WS_BIG + B_O);
    f32x4 lg[4], lb[4], ka[4], rk[4];
#pragma unroll
    for (int j = 0; j < 4; ++j) { lg[j] = ((const f32x4*)a.in[I_C_LN_G])[F.lane + 64 * j]; lb[j] = ((const f32x4*)a.in[I_C_LN_B])[F.lane + 64 * j];
        ka[j] = ((const f32x4*)a.in[I_C_K_A])[F.lane + 64 * j]; rk[j] = ((const f32x4*)a.in[I_C_R_K])[F.lane + 64 * j]; }
    for (int m = F.gw; m < T; m += F.NGW) {
        const size_t ro = (size_t)m * D;
        f32x4 y[4], r[4], k[4], aa[4], v[4]; u32x2 g[4];
#define LD4B(P) ({ const u32x2 _w = ((const u32x2*)((P) + ro))[F.lane + 64 * j]; (f32x4){bflo(_w.x), bfhi(_w.x), bflo(_w.y), bfhi(_w.y)}; })
#pragma unroll
        for (int j = 0; j < 4; ++j) { y[j] = LD4B(Y); r[j] = LD4B(Rg); k[j] = LD4B(Kg); aa[j] = LD4B(AA); v[j] = LD4B(Vg); g[j] = ((const u32x2*)(GG + ro))[F.lane + 64 * j]; }
#undef LD4B
#pragma unroll
        for (int j = 0; j < 4; ++j) {
            const float mean = reduce16((y[j].x + y[j].y) + (y[j].z + y[j].w)) * (1.0f / 64.0f);
            const f32x4 d = y[j] - mean;
            const float var = reduce16((d.x * d.x + d.y * d.y) + (d.z * d.z + d.w * d.w)) * (1.0f / 64.0f);
            const f32x4 yn = d * rsqrtf(var + 64e-5f) * lg[j] + lb[j];
            const f32x4 k2 = k[j] * ((aa[j] - 1.0f) * ka[j] + 1.0f), t = r[j] * k2 * rk[j];
            const float s = reduce16((t.x + t.y) + (t.z + t.w));
            const f32x4 o = yn + v[j] * s;
            u32x2 w; w.x = pk2(o.x * bflo(g[j].x), o.y * bfhi(g[j].x)); w.y = pk2(o.z * bflo(g[j].y), o.w * bfhi(g[j].y));
            ((u32x2*)(O + ro))[F.lane + 64 * j] = w;
        }
    }
}

enum { PH_PRO = 0, PH_A1_0, PH_SP_0, PH_A3_0, PH_NF_0, PH_F1_0, PH_F2_0, PH_NM_1, PH_B1, PH_POOL, PH_B2, PH_B3, PH_RT_0, PH_M1_0, PH_M2_0, PH_CB_0,
       PH_C1, PH_C2, PH_SCAN, PH_GN, PH_C5, PH_NF_2, PH_F1_1, PH_F2_1, PH_NM_3, PH_A1_1, PH_SP_1, PH_A3_1, PH_RT_1, PH_M1_1, PH_M2_1, PH_CB_1, N_PHASES };

__global__ void __launch_bounds__(NTHREADS, 2) fwd(Args args) {
    extern __shared__ __attribute__((aligned(16))) unsigned char lds_raw[];
    Frame F; F.lds = (LAS unsigned char*)lds_raw; F.tid = threadIdx.x; F.lane = F.tid & 63; F.wave = __builtin_amdgcn_readfirstlane(F.tid >> 6);
    F.gw = blockIdx.x * NWAVES + F.wave; F.NGW = gridDim.x * NWAVES; F.a = &args; F.ws = args.ws; F.X = args.out; F.XN = (bf16*)(args.ws + WS_XN);
    F.wsm = (bf16*)(args.ws + WS_WS); F.wmoe = (bf16*)(args.ws + WS_WM); F.ctl = (unsigned*)(args.ws + WS_CTL);
    volatile LAS unsigned* misc = (volatile LAS unsigned*)(F.lds + LDS_MISC);
    if (F.tid < 4) misc[F.tid] = 0u;
    __syncthreads();
    const int lo = args.ph_lo, hi = args.ph_hi;
    XcdBarrier bar; bar.bar = F.ctl + CW_BAR; bar.x = 0; bar.st = misc;
    if (hi - lo > 1) bar = xcd_barrier_post(F.ctl + CW_BAR, misc);
#define IN(k) (lo <= (k) && (k) < hi)
#define SEAM(k) do { if (IN(k) && IN((k) + 1)) xcd_barrier(bar); } while (0)
#ifndef REPEAT_MASK
#define REPEAT_MASK 0ull
#endif
#define PHASE(k, ...) do { if (IN(k)) { { __VA_ARGS__ } if ((REPEAT_MASK >> (k)) & 1ull) { xcd_barrier(bar); { __VA_ARGS__ } } } SEAM(k); } while (0)
    const float* nmix = args.in[I_NORM_MIX]; const float* nffn = args.in[I_NORM_FFN];
    unsigned char* big = F.ws + WS_BIG; const int G = (int)gridDim.x, cb = (int)blockIdx.x; float* X2 = (float*)(F.ws + WS_X2);
    if (lo > PH_CB_0) F.X = X2;
#define GPLAIN(EpiT, PAIRV, Ap, lda_, Bp, ldb_, N_, K_, agrp_, Eobj) do { pg8::PlainOrder S_{(const bf16*)(Ap), (const bf16*)(Bp), lda_, ldb_, T / 256, (N_) / 256, agrp_, G, cb, 0}; \
        pg8::gemm_phase<EpiT, pg8::PlainOrder, PAIRV, false, true>(F.lds, K_, lda_, ldb_, S_, Eobj); } while (0)
#define GMOE(EpiT, PAIRV, GATH, F8, Ap, lda_, Bp, bstr_, ldb_, nN_, K_, layer_, Eobj) do { pg8::MoeOrder S_; S_.A = (const char*)(Ap); S_.B = (const char*)(Bp); S_.bstride = bstr_; S_.lda = lda_; S_.ldb = ldb_; S_.nN = nN_; \
        S_.G = G; S_.c = cb; S_.gather = GATH; S_.esz = F8 ? 1 : 2; S_.slotTok = (const int*)(F.ws + WS_ROUTE + RT_SLOTTOK); S_.init(F.ctl + CW_CNT + 64 * (layer_)); \
        pg8::gemm_phase<EpiT, pg8::MoeOrder, PAIRV, GATH, true, F8>(F.lds, K_, lda_, ldb_, S_, Eobj); } while (0)
    PHASE(PH_PRO, ph_prologue(F););
    PHASE(PH_A1_0, EpiGeluUV E{(bf16*)(big + B_U), (bf16*)(big + B_V), (f32x2*)(big + B_VPART)}; GPLAIN(EpiGeluUV, false, F.XN, D, F.wsm + WA_IN, D, 2 * D, D, 0, E););
    PHASE(PH_SP_0, ph_spatial(F, 0););
    PHASE(PH_A3_0, EpiResid E{F.X, args.in[I_X]}; GPLAIN(EpiResid, false, big + B_GATED, D, F.wsm + WA_OUT, D, D, D, 0, E););
    PHASE(PH_NF_0, ph_norm(F, nffn + 0 * D););
    PHASE(PH_F1_0, EpiSwiglu E{(bf16*)(big + B_ACT)}; GPLAIN(EpiSwiglu, true, F.XN, D, F.wsm + WF_GU, D, 2 * FF, D, 0, E););
    PHASE(PH_F2_0, EpiResid E{F.X, F.X}; GPLAIN(EpiResid, false, big + B_ACT, FF, F.wsm + WF_D, FF, D, FF, 0, E););
    PHASE(PH_NM_1, ph_norm(F, nmix + 1 * D););
    PHASE(PH_B1, EpiScaleBf16 E{(bf16*)(big + B_P), nullptr}; GPLAIN(EpiScaleBf16, false, F.XN, D, F.wsm + WB_IN, D, D, D, 0, E););
    PHASE(PH_POOL, ph_pool(F););
    PHASE(PH_B2, EpiScaleBf16 E{(bf16*)(big + B_Y2), args.in[I_B_SCALE]}; GPLAIN(EpiScaleBf16, false, big + B_DD, D, F.wsm + WB_GRP, 256, D, 256, 1, E););
    PHASE(PH_B3, EpiResid E{F.X, F.X}; GPLAIN(EpiResid, false, big + B_Y2, D, F.wsm + WB_OUT, D, D, D, 0, E););
    PHASE(PH_RT_0, ph_route(F, 0, nffn + 1 * D, true););
    PHASE(PH_M1_0, EpiSwigluF8 E{(unsigned char*)(big + B_ACT), 1.0f / 32.0f, 8.0f}; GMOE(EpiSwigluF8, true, true, true, F.XN, D, F.wmoe, MWGU_STRIDE, D, 2 * FF / 256, D, 0, E););
    PHASE(PH_M2_0, EpiMulBf16 E{(bf16*)(big + B_YK), 1.0f / 256.0f}; GMOE(EpiMulBf16, false, false, true, big + B_ACT, FF, (unsigned char*)F.wmoe + MWD_OFF, MWD_STRIDE, FF, D / 256, FF, 0, E););
    PHASE(PH_CB_0, ph_combine(F, 0, nmix + 2 * D, 1, X2); CvtCtx c; c.gw = F.gw; c.NGW = F.NGW; c.lane = F.lane; c.base = 0; c.scr = (LAS float*)(F.lds + F.wave * 16640); cvt_moe(F, c, 1, true););
    F.X = X2;
    PHASE(PH_C1, EpiC1 E{(bf16*)(big + B_R), (bf16*)(big + B_HID)};
        { pg8::PlainOrder S_{(const bf16*)(big + B_H2), F.wsm + WC1L, 2 * D, 2 * D, T / 256, 1, 0, G, cb, 3 * D};
          pg8::gemm_phase<EpiC1, pg8::PlainOrder, false, false, true>(F.lds, 2 * D, 2 * D, 2 * D, S_, E); }
        { pg8::C1Order S_{(const bf16*)(big + B_XS), F.wsm + WC1, cb};
          pg8::gemm_phase<EpiC1, pg8::C1Order, false, false, true>(F.lds, D, D, D, S_, E); });
    PHASE(PH_C2, EpiC2 E{(float*)(big + B_DEC), (bf16*)(big + B_AA), (bf16*)(big + B_GG), args.in[I_C_W0], args.in[I_C_A0]}; GPLAIN(EpiC2, false, big + B_HID, 256, F.wsm + WC2, 256, 3072, 256, 0, E););
    PHASE(PH_SCAN, ph_scan(F););
    PHASE(PH_GN, ph_gnout(F););
    PHASE(PH_C5, EpiResid E{F.X, F.X}; GPLAIN(EpiResid, false, big + B_O, D, F.wsm + WC_O, D, D, D, 0, E););
    PHASE(PH_NF_2, ph_norm(F, nffn + 2 * D););
    PHASE(PH_F1_1, EpiSwiglu E{(bf16*)(big + B_ACT)}; GPLAIN(EpiSwiglu, true, F.XN, D, F.wsm + WF_GU + (size_t)2 * FF * D, D, 2 * FF, D, 0, E););
    PHASE(PH_F2_1, EpiResid E{F.X, F.X}; GPLAIN(EpiResid, false, big + B_ACT, FF, F.wsm + WF_D + (size_t)D * FF, FF, D, FF, 0, E););
    PHASE(PH_NM_3, ph_norm(F, nmix + 3 * D););
    PHASE(PH_A1_1, EpiGeluUV E{(bf16*)(big + B_U), (bf16*)(big + B_V), (f32x2*)(big + B_VPART)}; GPLAIN(EpiGeluUV, false, F.XN, D, F.wsm + WA_IN + (size_t)2 * D * D, D, 2 * D, D, 0, E););
    PHASE(PH_SP_1, ph_spatial(F, 1););
    PHASE(PH_A3_1, EpiResid E{F.X, F.X}; GPLAIN(EpiResid, false, big + B_GATED, D, F.wsm + WA_OUT + (size_t)D * D, D, D, D, 0, E););
    PHASE(PH_RT_1, ph_route(F, 1, nffn + 3 * D, true););
    PHASE(PH_M1_1, EpiSwigluF8 E{(unsigned char*)(big + B_ACT), 1.0f / 32.0f, 8.0f}; GMOE(EpiSwigluF8, true, true, true, F.XN, D, F.wmoe, MWGU_STRIDE, D, 2 * FF / 256, D, 1, E););
    PHASE(PH_M2_1, EpiMulBf16 E{(bf16*)(big + B_YK), 1.0f / 256.0f}; GMOE(EpiMulBf16, false, false, true, big + B_ACT, FF, (unsigned char*)F.wmoe + MWD_OFF, MWD_STRIDE, FF, D / 256, FF, 1, E););
    if (IN(PH_CB_1)) { ph_combine(F, 1, args.in[I_NORM_FINAL], 2, args.out); }
#undef GPLAIN
#undef GMOE
#undef IN
#undef SEAM
#undef PHASE
}

extern "C" void kernel_launch(void* const* d_in, const int* in_sizes, int n_in, void* d_out, int out_size, void* d_ws, size_t ws_size, hipStream_t stream) {
    static int grid = 0;
    if (grid == 0) {
        if (n_in != N_IN || out_size != T * D || ws_size < WS_END) { fprintf(stderr, "kernel_launch: unexpected shapes (n_in %d out %d ws %zu)\n", n_in, out_size, ws_size); grid = -1; return; }
        int dev = 0, cus = 0; hipGetDevice(&dev); hipDeviceGetAttribute(&cus, hipDeviceAttributeMultiprocessorCount, dev);
        if (hipFuncSetAttribute((const void*)fwd, hipFuncAttributeMaxDynamicSharedMemorySize, LDS_BYTES) != hipSuccess) { grid = -1; return; }
        grid = cus > 0 ? cus : 256;
    }
    if (grid < 0) return;
    hipMemsetAsync((char*)d_ws + WS_CTL, 0, CTL_ZERO_BYTES, stream);
    Args a{}; for (int i = 0; i < N_IN; ++i) a.in[i] = (const float*)d_in[i];
    a.out = (float*)d_out; a.ws = (unsigned char*)d_ws;
    auto thin = [&](int ph) { a.ph_lo = ph; a.ph_hi = ph + 1; hipLaunchKernelGGL(fwd, dim3(grid), dim3(NTHREADS), LDS_BYTES, stream, a); };
#ifndef ONE_LAUNCH
#define ONE_LAUNCH 1
#endif
    if (ONE_LAUNCH) { a.ph_lo = 0; a.ph_hi = N_PHASES; hipLaunchKernelGGL(fwd, dim3(grid), dim3(NTHREADS), LDS_BYTES, stream, a); return; }
    for (int ph = 0; ph < N_PHASES; ++ph) thin(ph);
}
```
